# Optimizing an MI355X kernel written in HIP

```python
import jax, jax.numpy as jnp
from jax import lax
import numpy as np

D_MODEL = 1024
BATCH = 8
SEQ = 4096
DEPTH = 1

GRID_W = 64
CTX_LEN = 256
D_MIX = D_MODEL
ML_HEADS = 4
ML_HEAD_DIM = 128
ML_WIDTH = ML_HEADS * ML_HEAD_DIM
HG_HEADS = 4
HG_HEAD_DIM = 128
HG_WIDTH = HG_HEADS * HG_HEAD_DIM
ML_COLS = 4 * ML_WIDTH + 4 * ML_HEADS
HG_COLS = 5 * HG_WIDTH
IN_COLS = ML_COLS + HG_COLS
CONV_W = 3
D_FF = 2816
ML_CHUNK = 64
HG_CHUNK = 32
N_MOD = 6
EPS = 1e-6

kernel_name = "hybrid_mlstm_hgrn2_convffn_prefix_block"

F32 = jnp.float32


def _rmsnorm(x, w):
    xf = x.astype(F32)
    y = xf * lax.rsqrt(jnp.mean(xf * xf, axis=-1, keepdims=True) + EPS)
    return (y * w.astype(F32)).astype(x.dtype)


def _modulate(h, shift, scale):
    return h * (1 + scale) + shift


def _head_rmsnorm(h, w):
    B, H, T, d = h.shape
    y = h * lax.rsqrt(jnp.mean(h * h, axis=-1, keepdims=True) + EPS)
    y = jnp.transpose(y, (0, 2, 1, 3)).reshape(B, T, H * d)
    return y * w.astype(F32)


def _to_heads(a, n_heads):
    B, T, C = a.shape
    return jnp.transpose(a.reshape(B, T, n_heads, C // n_heads), (0, 2, 1, 3)).astype(F32)


def _dwconv2d(x, w, rows, cols):
    B, T, C = x.shape
    img = x.reshape(B, rows, cols, C)
    out = lax.conv_general_dilated(img, w[:, :, None, :].astype(x.dtype), (1, 1), 'SAME',
                                   dimension_numbers=('NHWC', 'HWIO', 'NHWC'), feature_group_count=C)
    return out.reshape(B, T, C)


def _chunks(a, L):
    B, H, T = a.shape[:3]
    a = a.reshape(B, H, T // L, L, *a.shape[3:])
    return jnp.moveaxis(a, 2, 0)


def _unchunks(a):
    nc, B, H, L, d = a.shape
    return jnp.moveaxis(a, 0, 2).reshape(B, H, nc * L, d)


def _mlstm_scan(q, k, v, ig, lf, state):
    L = ML_CHUNK
    causal = jnp.tril(jnp.ones((L, L), bool))

    def step(carry, inp):
        C, n, m = carry
        qc, kc, vc, ic, fc = inp
        b = jnp.cumsum(fc, axis=-1)
        dlog = jnp.where(causal, b[..., :, None] - b[..., None, :] + ic[..., None, :], -jnp.inf)
        inter = b + m[..., None]
        mt = jnp.maximum(inter, jnp.max(dlog, axis=-1))
        w_intra = jnp.exp(dlog - mt[..., None])
        w_inter = jnp.exp(inter - mt)
        s = jnp.einsum('bhtd,bhsd->bhts', qc, kc) * w_intra
        num = jnp.einsum('bhts,bhsv->bhtv', s, vc) + w_inter[..., None] * jnp.einsum('bhtd,bhdv->bhtv', qc, C)
        den = jnp.sum(s, axis=-1) + w_inter * jnp.einsum('bhtd,bhd->bht', qc, n)
        h = num / jnp.maximum(jnp.abs(den), jnp.exp(-mt))[..., None]
        bL = b[..., -1]
        wlog = bL[..., None] - b + ic
        m_new = jnp.maximum(bL + m, jnp.max(wlog, axis=-1))
        decay = jnp.exp(bL + m - m_new)
        ws = jnp.exp(wlog - m_new[..., None])
        C_new = decay[..., None, None] * C + jnp.einsum('bhs,bhsd,bhsv->bhdv', ws, kc, vc)
        n_new = decay[..., None] * n + jnp.einsum('bhs,bhsd->bhd', ws, kc)
        return (C_new, n_new, m_new), h

    state, hs = lax.scan(step, state, tuple(_chunks(a, L) for a in (q, k, v, ig, lf)))
    return _unchunks(hs), state


def _hgrn_scan(q, k, v, lf, S):
    L = HG_CHUNK
    causal = jnp.tril(jnp.ones((L, L), bool))[:, :, None]

    def step(S, inp):
        qc, kc, vc, fc = inp
        b = jnp.cumsum(fc, axis=2)
        rel = jnp.where(causal, b[:, :, :, None, :] - b[:, :, None, :, :], -jnp.inf)
        a = jnp.einsum('bhtk,bhtsk,bhsk->bhts', qc, jnp.exp(rel), kc)
        o = jnp.einsum('bhts,bhsv->bhtv', a, vc) + jnp.einsum('bhtk,bhkv->bhtv', qc * jnp.exp(b), S)
        bL = b[:, :, -1]
        S_new = jnp.exp(bL)[..., None] * S + jnp.einsum('bhsk,bhsv->bhkv', kc * jnp.exp(bL[:, :, None] - b), vc)
        return S_new, o

    S, os_ = lax.scan(step, S, tuple(_chunks(a, L) for a in (q, k, v, lf)))
    return _unchunks(os_), S


def _bidir(scan_fn, ctx_f, ctx_b, lat_f, lat_b, init):
    flip = lambda a: jnp.flip(a, axis=2)
    hc_f, st_f = scan_fn(*ctx_f, init)
    hl_f, _ = scan_fn(*lat_f, st_f)
    hc_b, st_b = scan_fn(*(flip(a) for a in ctx_b), init)
    hl_b, _ = scan_fn(*(flip(a) for a in lat_b), st_b)
    return hl_f + flip(hl_b), hc_f + flip(hc_b)


def _mlstm_prep(p, conv_w, gate_b, rows, cols):
    W, H = ML_WIDTH, ML_HEADS
    qk = jax.nn.silu(_dwconv2d(p[..., :2 * W], conv_w, rows, cols))
    q = _to_heads(qk[..., :W], H) * (ML_HEAD_DIM ** -0.5)
    k = _to_heads(qk[..., W:], H)
    v = _to_heads(p[..., 2 * W:3 * W], H)
    o = p[..., 3 * W:4 * W]
    g = jnp.transpose(p[..., 4 * W:].astype(F32) + gate_b.astype(F32), (0, 2, 1))
    i_f, f_f, i_b, f_b = jnp.split(g, 4, axis=1)
    return q, k, v, o, (i_f, jax.nn.log_sigmoid(f_f)), (i_b, jax.nn.log_sigmoid(f_b))


def _mlstm_mixer(pl, pc, conv_w, gate_b, norm_w, rows, need_ctx):
    ql, kl, vl, ol, gfl, gbl = _mlstm_prep(pl, conv_w, gate_b, rows, GRID_W)
    qc, kc, vc, oc, gfc, gbc = _mlstm_prep(pc, conv_w, gate_b, 1, pc.shape[1])
    B = pl.shape[0]
    init = (jnp.zeros((B, ML_HEADS, ML_HEAD_DIM, ML_HEAD_DIM), F32),
            jnp.zeros((B, ML_HEADS, ML_HEAD_DIM), F32),
            jnp.zeros((B, ML_HEADS), F32))
    hl, hc = _bidir(_mlstm_scan, (qc, kc, vc) + gfc, (qc, kc, vc) + gbc,
                    (ql, kl, vl) + gfl, (ql, kl, vl) + gbl, init)
    out = lambda h, o: (_head_rmsnorm(h, norm_w) * jax.nn.sigmoid(o.astype(F32))).astype(pl.dtype)
    return out(hl, ol), (out(hc, oc) if need_ctx else None)


def _hgrn_prep(p, lb):
    W, H = HG_WIDTH, HG_HEADS
    pf = p.astype(F32)
    q = _to_heads(jax.nn.silu(pf[..., :W]), H) * (HG_HEAD_DIM ** -0.5)
    v = _to_heads(pf[..., 3 * W:4 * W], H)
    g = p[..., 4 * W:5 * W]
    dirs = []
    for j in range(2):
        z = pf[..., (1 + j) * W:(2 + j) * W]
        lbj = lb[j]
        lf = jnp.logaddexp(jnp.log(lbj), jnp.log1p(-lbj) + jax.nn.log_sigmoid(z))
        k = (1 - lbj) * jax.nn.sigmoid(-z)
        dirs.append((q, _to_heads(k, H), v, _to_heads(lf, H)))
    return dirs[0], dirs[1], g


def _hgrn_mixer(pl, pc, lb, norm_w, need_ctx):
    lat_f, lat_b, gl = _hgrn_prep(pl, lb)
    ctx_f, ctx_b, gc = _hgrn_prep(pc, lb)
    B = pl.shape[0]
    init = jnp.zeros((B, HG_HEADS, HG_HEAD_DIM, HG_HEAD_DIM), F32)
    hl, hc = _bidir(_hgrn_scan, ctx_f, ctx_b, lat_f, lat_b, init)
    out = lambda h, g: (_head_rmsnorm(h, norm_w) * jax.nn.silu(g.astype(F32))).astype(pl.dtype)
    return out(hl, gl), (out(hc, gc) if need_ctx else None)


def _conv_ffn(h, w_up, conv_w, w_down, rows, cols):
    u = _dwconv2d(h @ w_up, conv_w, rows, cols)
    a, b = jnp.split(u, 2, axis=-1)
    return (jax.nn.silu(a) * b) @ w_down


def setup_inputs(seed: int = 0) -> dict:
    key = jax.random.key(seed)
    ks = jax.random.split(key, 24)
    nrm = lambda k, shape, s: jax.random.normal(k, shape, F32) * s
    L, D = DEPTH, D_MODEL
    gate_b = jnp.concatenate([
        nrm(ks[8], (L, ML_HEADS), 0.1),
        jnp.linspace(3.0, 6.0, ML_HEADS, dtype=F32)[None] + nrm(ks[9], (L, ML_HEADS), 0.1),
        nrm(ks[10], (L, ML_HEADS), 0.1),
        jnp.linspace(3.0, 6.0, ML_HEADS, dtype=F32)[None] + nrm(ks[11], (L, ML_HEADS), 0.1)], axis=-1)
    return {
        "x": nrm(ks[0], (BATCH, SEQ, D), 1.0),
        "c": nrm(ks[1], (BATCH, D), 1.0),
        "ctx": nrm(ks[2], (BATCH, CTX_LEN, D), 1.0),
        "c_ctx": nrm(ks[3], (D,), 1.0),
        "w_mod": nrm(ks[4], (L, D, N_MOD * D), D ** -0.5),
        "b_mod": nrm(ks[5], (L, N_MOD * D), 0.02),
        "norm1_w": 1.0 + nrm(ks[6], (L, D), 0.05),
        "w_in": nrm(ks[7], (L, D, IN_COLS), D ** -0.5),
        "mlstm_gate_b": gate_b,
        "mlstm_conv_w": nrm(ks[12], (L, CONV_W, CONV_W, 2 * ML_WIDTH), 1.0 / CONV_W),
        "mlstm_norm_w": 1.0 + nrm(ks[13], (L, ML_WIDTH), 0.05),
        "hgrn_lb_logits": nrm(ks[14], (2, L + 1, HG_WIDTH), 0.1),
        "hgrn_norm_w": 1.0 + nrm(ks[15], (L, HG_WIDTH), 0.05),
        "w_out": nrm(ks[16], (L, D_MIX, D), D_MIX ** -0.5),
        "norm2_w": 1.0 + nrm(ks[17], (L, D), 0.05),
        "w_up": nrm(ks[18], (L, D, 2 * D_FF), D ** -0.5),
        "ffn_conv_w": nrm(ks[19], (L, CONV_W, CONV_W, 2 * D_FF), 1.0 / CONV_W),
        "w_down": nrm(ks[20], (L, D_FF, D), D_FF ** -0.5),
        "final_norm_w": 1.0 + nrm(ks[21], (D,), 0.05),
    }


def reference(x, c, ctx, c_ctx, w_mod, b_mod, norm1_w, w_in, mlstm_gate_b, mlstm_conv_w, mlstm_norm_w,
              hgrn_lb_logits, hgrn_norm_w, w_out, norm2_w, w_up, ffn_conv_w, w_down, final_norm_w):
    rows = x.shape[1] // GRID_W
    ctx_len = ctx.shape[1]
    lower_bounds = jnp.cumsum(jax.nn.softmax(hgrn_lb_logits.astype(F32), axis=1), axis=1)
    xl, xc = x, ctx
    for l in range(DEPTH):
        last = l == DEPTH - 1
        mod_l = (jax.nn.silu(c) @ w_mod[l] + b_mod[l])[:, None, :]
        mod_c = (jax.nn.silu(c_ctx) @ w_mod[l] + b_mod[l])[None, None, :]
        sh1, sc1, g1, sh2, sc2, g2 = jnp.split(mod_l, N_MOD, axis=-1)
        sh1c, sc1c, g1c, sh2c, sc2c, g2c = jnp.split(mod_c, N_MOD, axis=-1)
        pl = _modulate(_rmsnorm(xl, norm1_w[l]), sh1, sc1) @ w_in[l]
        pc = _modulate(_rmsnorm(xc, norm1_w[l]), sh1c, sc1c) @ w_in[l]
        ml_l, ml_c = _mlstm_mixer(pl[..., :ML_COLS], pc[..., :ML_COLS], mlstm_conv_w[l], mlstm_gate_b[l],
                                  mlstm_norm_w[l], rows, not last)
        hg_l, hg_c = _hgrn_mixer(pl[..., ML_COLS:], pc[..., ML_COLS:], lower_bounds[:, l], hgrn_norm_w[l], not last)
        xl = xl + g1 * (jnp.concatenate([ml_l, hg_l], axis=-1) @ w_out[l])
        xl = xl + g2 * _conv_ffn(_modulate(_rmsnorm(xl, norm2_w[l]), sh2, sc2), w_up[l], ffn_conv_w[l],
                                 w_down[l], rows, GRID_W)
        if not last:
            xc = xc + g1c * (jnp.concatenate([ml_c, hg_c], axis=-1) @ w_out[l])
            xc = xc + g2c * _conv_ffn(_modulate(_rmsnorm(xc, norm2_w[l]), sh2c, sc2c), w_up[l], ffn_conv_w[l],
                                      w_down[l], 1, ctx_len)
    return _rmsnorm(xl, final_norm_w)
```

```cpp
#include <hip/hip_runtime.h>
#include <hip/hip_cooperative_groups.h>
#include <cstdio>
namespace cg = cooperative_groups;

#define LAS __attribute__((address_space(3)))
typedef unsigned short bf16_t;
typedef short bf16x8 __attribute__((ext_vector_type(8)));
typedef float f32x4 __attribute__((ext_vector_type(4)));
typedef float f32x2 __attribute__((ext_vector_type(2)));
typedef unsigned u32x4 __attribute__((ext_vector_type(4)));
typedef unsigned u32x2 __attribute__((ext_vector_type(2)));


constexpr int NT = 512;
constexpr int LDS_BYTES = 147456;
constexpr size_t MiB = 1048576;
constexpr int NROWS = 34816, NLAT = 32768, NPC = 4608;
constexpr size_t WS_WIN = 0, WS_WOUT = 9 * MiB, WS_WUP = 11 * MiB, WS_WDN = 22 * MiB, WS_MOD = 28 * MiB, WS_GATES = 29 * MiB, WS_SMALL = 32 * MiB;
constexpr size_t WS_R1 = 34 * MiB, WS_P = 102 * MiB, WS_Y = 408 * MiB, WS_U = 34 * MiB, WS_A2 = 448 * MiB, WS_ACTA = 386 * MiB, WS_ACTB = 34 * MiB, WS_NEED = 512 * MiB;
constexpr size_t WS_PARK = 472 * MiB;
constexpr size_t SM_MLN = 0, SM_HGB = 512 * 1024, SM_MLOC = 1024 * 1024, SM_MLB = 1024 * 1024 + 4096, SM_MPRE = 1024 * 1024 + 8192;

struct Args {
    const float *x, *c, *ctx, *c_ctx, *w_mod, *b_mod, *norm1_w, *w_in, *gate_b, *ml_conv_w, *ml_norm_w, *lb_logits, *hg_norm_w, *w_out, *norm2_w, *w_up, *ffn_conv_w, *w_down, *final_w;
    float* out; unsigned char* ws; int ph_lo, ph_hi;
};

__device__ __forceinline__ float bf2f(unsigned short h) { return __uint_as_float(((unsigned)h) << 16); }
typedef __bf16 bf16x2n __attribute__((ext_vector_type(2)));
__device__ __forceinline__ unsigned pack2(float lo, float hi) { const f32x2 v = {lo, hi}; return __builtin_bit_cast(unsigned, __builtin_convertvector(v, bf16x2n)); }
__device__ __forceinline__ unsigned short f2bf(float f) { return (unsigned short)pack2(f, f); }
__device__ __forceinline__ float lo_f(unsigned u) { return __uint_as_float(u << 16); }
__device__ __forceinline__ float hi_f(unsigned u) { return __uint_as_float(u & 0xffff0000u); }
__device__ __forceinline__ float sigm(float x) { return __builtin_amdgcn_rcpf(1.f + __expf(-x)); }
__device__ __forceinline__ float silu(float x) { return x * __builtin_amdgcn_rcpf(1.f + __expf(-x)); }
__device__ __forceinline__ float logsig(float x) { return fminf(x, 0.f) - log1pf(__expf(-fabsf(x))); }
__device__ __forceinline__ float wsum(float v) {
#pragma unroll
    for (int o = 32; o; o >>= 1) v += __shfl_xor(v, o); return v; }
__device__ __forceinline__ float wmaxr(float v) {
#pragma unroll
    for (int o = 32; o; o >>= 1) v = fmaxf(v, __shfl_xor(v, o)); return v; }
__device__ __forceinline__ float wscan_add(float v, int lane) {
#pragma unroll
    for (int o = 1; o < 64; o <<= 1) { float t = __shfl_up(v, o); if (lane >= o) v += t; } return v; }
__device__ __forceinline__ float wscan_max(float v, int lane) {
#pragma unroll
    for (int o = 1; o < 64; o <<= 1) { float t = __shfl_up(v, o); if (lane >= o) v = fmaxf(v, t); } return v; }
__device__ __forceinline__ float red16(float v) { v += __shfl_xor(v, 1); v += __shfl_xor(v, 2); v += __shfl_xor(v, 4); v += __shfl_xor(v, 8); return v; }
__device__ __forceinline__ void wave_lds_sync() { __builtin_amdgcn_fence(__ATOMIC_RELEASE, "workgroup"); __builtin_amdgcn_wave_barrier(); __builtin_amdgcn_fence(__ATOMIC_ACQUIRE, "workgroup"); }
__device__ __forceinline__ int ltid() { int t = threadIdx.x; asm volatile("" : "+v"(t)); return t; }
__device__ __forceinline__ int lbid() { int t = blockIdx.x; asm volatile("" : "+s"(t)); return t; }
#define MFMA16(a, b, c) __builtin_amdgcn_mfma_f32_16x16x32_bf16((a), (b), (c), 0, 0, 0)

namespace pg8 {
constexpr int BM = 256, BK = 64, HALF = 128, HTB = HALF * BK * 2, STAGE_BYTES = 8 * HTB, NXCD = 8, WGM = 8;
__device__ __forceinline__ int lds_byte(int r, int c) { const int st = (r >> 4) * 2 + (c >> 5), rr = r & 15, cc = c & 31, ob = rr * 64 + cc * 2; return st * 1024 + (ob ^ (((ob >> 9) & 1) << 5)); }
__device__ __forceinline__ void stage_rc(int b, int& R, int& C) { const int st = b / 1024, sb = b % 1024, swz = sb ^ (((sb >> 9) & 1) << 5); R = (st >> 1) * 16 + swz / 64; C = (st & 1) * 32 + (swz % 64) / 2; }
__device__ __forceinline__ int perm32(int rho) { const int n = rho >> 4, i = rho & 15; return 8 * (i >> 2) + 4 * n + (i & 3); }
struct Unit { int pm, pn; };
struct Gemm { const bf16_t* A; const bf16_t* A_hi; int pm_split; const bf16_t* Bt; int M, N, K; };
struct StaticOrder {
    int nM, nN, nwg, G, c;
    __device__ void init(int M, int N, int G_, int c_) { nM = M / BM; nN = N / BM; nwg = nM * nN; G = G_; c = c_; }
    __device__ bool next(int i, Unit& u) const {
        const long L = (long)i * G + c; if (L >= nwg) return false;
        int wgid = (int)L; { const int q = nwg / NXCD, r = nwg % NXCD, xcd = wgid % NXCD, off = wgid / NXCD; wgid = (xcd < r ? xcd * (q + 1) : r * (q + 1) + (xcd - r) * q) + off; }
        const int nig = WGM * nN, gid = wgid / nig, fm = gid * WGM, gsz = (nM - fm) < WGM ? (nM - fm) : WGM;
        u.pm = fm + ((wgid % nig) % gsz); u.pn = (wgid % nig) / gsz; return true;
    }
};
__device__ __forceinline__ unsigned cvt_pk_bf16(float lo, float hi) { return pack2(lo, hi); }

template <bool ACT> struct EpiBf16 {
    static constexpr bool PERM = true;
    bf16_t* O; int ldc;
    __device__ __forceinline__ f32x4 act(f32x4 v, int mode) const {
        if (!ACT || mode == 0) return v;
        f32x4 o;
#pragma unroll
        for (int j = 0; j < 4; ++j) { const float s = __builtin_amdgcn_rcpf(1.f + __expf(-v[j])); o[j] = mode == 1 ? s : (mode == 2 ? v[j] * s * 0.08838834764831845f : v[j] * s); }
        return o; }
    __device__ __forceinline__ void operator()(const f32x4 (&acc)[2][2][4][2], const Unit& u, int wr, int wc, int fr, int fq) const {
        const int mode = !ACT ? 0 : ((u.pn == 6 || u.pn == 7) ? 1 : ((u.pn == 8 || u.pn == 9) ? 2 : ((u.pn == 16 || u.pn == 17) ? 3 : 0)));
        const int row0 = u.pm * BM + wr * 64 + fr; const int col0 = u.pn * BM + wc * 32 + 8 * fq;
#pragma unroll
        for (int ai = 0; ai < 2; ++ai)
#pragma unroll
            for (int m = 0; m < 4; ++m) { bf16_t* rowp = O + (size_t)(row0 + ai * HALF + m * 16) * ldc + col0;
#pragma unroll
                for (int bj = 0; bj < 2; ++bj) { const f32x4 v0 = act(acc[ai][bj][m][0], mode), v1 = act(acc[ai][bj][m][1], mode);
                    u32x4 w; w.x = cvt_pk_bf16(v0[0], v0[1]); w.y = cvt_pk_bf16(v0[2], v0[3]); w.z = cvt_pk_bf16(v1[0], v1[1]); w.w = cvt_pk_bf16(v1[2], v1[3]);
                    __builtin_nontemporal_store(w, (u32x4*)(rowp + bj * HALF)); } }
    }
};
struct EpiRes {
    static constexpr bool PERM = false;
    const float* base; float* out; const float* gate;
    __device__ __forceinline__ void operator()(const f32x4 (&acc)[2][2][4][2], const Unit& u, int wr, int wc, int fr, int fq) const {
        const int row0 = u.pm * BM + wr * 64 + fr, col0 = u.pn * BM + wc * 32 + 4 * fq;
        const float* gp = gate + (size_t)(u.pm >> 4) * 6144 + col0;
        f32x4 gv[2][2];
#pragma unroll
        for (int bj = 0; bj < 2; ++bj)
#pragma unroll
            for (int n = 0; n < 2; ++n) gv[bj][n] = *(const f32x4*)(gp + bj * HALF + n * 16);
#pragma unroll
        for (int ai = 0; ai < 2; ++ai)
#pragma unroll
            for (int m = 0; m < 4; ++m) { const size_t ro = (size_t)(row0 + ai * HALF + m * 16) * 1024 + col0;
#pragma unroll
                for (int bj = 0; bj < 2; ++bj)
#pragma unroll
                    for (int n = 0; n < 2; ++n) { f32x4 b = *(const f32x4*)(base + ro + bj * HALF + n * 16); __builtin_nontemporal_store(b + gv[bj][n] * acc[ai][bj][m][n], (f32x4*)(out + ro + bj * HALF + n * 16)); } }
    }
};

template <class Epi, bool ALIGN_EPI = true, bool SP2 = true>
__device__ __forceinline__ void gemm_phase(LAS unsigned char* lds, const Gemm g, const StaticOrder& S, const Epi& E) {
    const int tid = ltid(), wid = __builtin_amdgcn_readfirstlane(tid >> 6), lane = tid & 63, wr = wid >> 2, wc = wid & 3, fr = lane & 15, fq = lane >> 4;
    const int K = g.K, nt = K / BK;
    unsigned voffA[2], voffB[2];
#pragma unroll
    for (int i = 0; i < 2; ++i) { int R, C; stage_rc(tid * 16 + i * 8192, R, C); const int Rb = Epi::PERM ? ((R & ~31) + perm32(R & 31)) : R;
        voffA[i] = (unsigned)(R * K + C) * 2u; voffB[i] = (unsigned)(Rb * K + C) * 2u; }
    const size_t kstep = (size_t)(BK * 2);
    const size_t hstep = (size_t)HALF * K * 2;
    const size_t tstep = 2 * hstep;
    const unsigned ldsw = (unsigned)wid * 1024u;
    const int aoff = lds_byte(wr * 64 + fr, fq * 8), boff = lds_byte(wc * 32 + fr, fq * 8);
#define PG8_APTR(pm) ((pm) < g.pm_split ? (const char*)g.A + (size_t)(pm) * tstep : (const char*)g.A_hi + (size_t)((pm) - g.pm_split) * tstep)
#define PG8_SA(b, h) (((b) * 2 + (h)) * HTB)
#define PG8_SB(b, h) ((4 + (b) * 2 + (h)) * HTB)
#define PG8_STAGE(bufoff, gbase, voff) do { _Pragma("unroll") for (int _i = 0; _i < 2; ++_i) \
        __builtin_amdgcn_global_load_lds((const unsigned*)((const char*)(gbase) + (voff)[_i]), (LAS unsigned*)(lds + (bufoff) + ldsw + _i * 8192), 16, 0, 0); } while (0)
#define PG8_LDA(dst, b, h) do { _Pragma("unroll") for (int m = 0; m < 4; ++m) _Pragma("unroll") for (int k = 0; k < 2; ++k) dst[m][k] = *(const LAS bf16x8*)(lds + PG8_SA(b, h) + aoff + m * 2048 + k * 1024); } while (0)
#define PG8_LDB(dst, b, h) do { _Pragma("unroll") for (int n = 0; n < 2; ++n) _Pragma("unroll") for (int k = 0; k < 2; ++k) dst[n][k] = *(const LAS bf16x8*)(lds + PG8_SB(b, h) + boff + n * 2048 + k * 1024); } while (0)
#define PG8_MMA(ai, bj, At, Bt) do { __builtin_amdgcn_s_setprio(1); _Pragma("unroll") for (int m = 0; m < 4; ++m) _Pragma("unroll") for (int n = 0; n < 2; ++n) _Pragma("unroll") for (int k = 0; k < 2; ++k) \
        acc[ai][bj][m][n] = __builtin_amdgcn_mfma_f32_16x16x32_bf16(Bt[n][k], At[m][k], acc[ai][bj][m][n], 0, 0, 0); __builtin_amdgcn_s_setprio(0); } while (0)
#define PG8_WAIT_V(n) asm volatile("s_waitcnt vmcnt(" #n ")" ::: "memory")
#define PG8_WAIT_L(n) asm volatile("s_waitcnt lgkmcnt(" #n ")" ::: "memory")
#define PG8_BAR __builtin_amdgcn_s_barrier()
#define PG8_SCHED __builtin_amdgcn_sched_barrier(0)
    Unit cur, nxt; int ui = 0;
    if (!S.next(0, cur)) return;
    f32x4 acc[2][2][4][2];
#pragma unroll
    for (int a = 0; a < 2; ++a)
#pragma unroll
        for (int b = 0; b < 2; ++b)
#pragma unroll
            for (int m = 0; m < 4; ++m)
#pragma unroll
                for (int n = 0; n < 2; ++n) acc[a][b][m][n] = (f32x4){0.f, 0.f, 0.f, 0.f};
    bf16x8 At[4][2], B0[2][2], B1[2][2];
    const char* cA = PG8_APTR(cur.pm); const char* cB = (const char*)g.Bt + (size_t)cur.pn * tstep;
    if constexpr (SP2) {
        PG8_STAGE(PG8_SB(0, 0), cB, voffB); PG8_STAGE(PG8_SB(0, 1), cB + hstep, voffB); PG8_STAGE(PG8_SA(0, 0), cA, voffA); PG8_STAGE(PG8_SA(0, 1), cA + hstep, voffA);
        if (wr == 1) PG8_BAR;
        PG8_WAIT_V(2); PG8_BAR;
        PG8_STAGE(PG8_SB(1, 0), cB + kstep, voffB); PG8_STAGE(PG8_SA(1, 0), cA + kstep, voffA); PG8_STAGE(PG8_SB(1, 1), cB + hstep + kstep, voffB);
        PG8_WAIT_V(6); PG8_BAR;
    } else {
        PG8_STAGE(PG8_SB(0, 0), cB, voffB); PG8_STAGE(PG8_SA(0, 0), cA, voffA); PG8_STAGE(PG8_SB(0, 1), cB + hstep, voffB); PG8_STAGE(PG8_SA(0, 1), cA + hstep, voffA);
        if (wr == 1) PG8_BAR;
        PG8_WAIT_V(4); PG8_BAR;
        PG8_STAGE(PG8_SB(1, 0), cB + kstep, voffB); PG8_STAGE(PG8_SA(1, 0), cA + kstep, voffA); PG8_STAGE(PG8_SB(1, 1), cB + hstep + kstep, voffB);
        PG8_WAIT_V(6); PG8_BAR;
    }
    for (;;) {
        const bool has_next = S.next(ui + 1, nxt);
        const char* nA = has_next ? PG8_APTR(nxt.pm) : cA; const char* nB = has_next ? (const char*)g.Bt + (size_t)nxt.pn * tstep : cB;
        for (int t = 0; t < nt; t += 2) {
            const bool last = (t == nt - 2);
            const char* a1 = cA + (size_t)(t + 1) * kstep;
            const char* a2 = last ? nA : cA + (size_t)(t + 2) * kstep; const char* b2 = last ? nB : cB + (size_t)(t + 2) * kstep;
            const char* a3 = a2 + kstep; const char* b3 = b2 + kstep;
            if constexpr (SP2) {
            PG8_LDB(B0, 0, 0); PG8_LDB(B1, 0, 1); PG8_SCHED; PG8_LDA(At, 0, 0); PG8_STAGE(PG8_SA(1, 1), a1 + hstep, voffA);
            PG8_WAIT_V(8); PG8_WAIT_L(0); PG8_BAR; PG8_MMA(0, 0, At, B0); PG8_MMA(0, 1, At, B1); PG8_BAR; PG8_SCHED;
            PG8_LDA(At, 0, 1); PG8_STAGE(PG8_SB(0, 0), b2, voffB); PG8_STAGE(PG8_SB(0, 1), b2 + hstep, voffB); PG8_STAGE(PG8_SA(0, 0), a2, voffA);
            PG8_WAIT_V(8); PG8_WAIT_L(0); PG8_BAR; PG8_MMA(1, 0, At, B0); PG8_MMA(1, 1, At, B1); PG8_BAR; PG8_SCHED;
            PG8_LDB(B0, 1, 0); PG8_LDB(B1, 1, 1); PG8_SCHED; PG8_LDA(At, 1, 0); PG8_STAGE(PG8_SA(0, 1), a2 + hstep, voffA);
            PG8_WAIT_V(8); PG8_WAIT_L(0); PG8_BAR; PG8_MMA(0, 0, At, B0); PG8_MMA(0, 1, At, B1); PG8_BAR; PG8_SCHED;
            PG8_LDA(At, 1, 1); PG8_STAGE(PG8_SB(1, 0), b3, voffB); PG8_STAGE(PG8_SB(1, 1), b3 + hstep, voffB); PG8_STAGE(PG8_SA(1, 0), a3, voffA);
            PG8_WAIT_V(8); PG8_WAIT_L(0); PG8_BAR; PG8_MMA(1, 0, At, B0); PG8_MMA(1, 1, At, B1); PG8_BAR; PG8_SCHED;
            } else {
            PG8_LDB(B0, 0, 0); PG8_SCHED; PG8_LDA(At, 0, 0); PG8_STAGE(PG8_SA(1, 1), a1 + hstep, voffA);
            PG8_WAIT_L(8); PG8_BAR; PG8_WAIT_L(0); PG8_MMA(0, 0, At, B0); PG8_BAR; PG8_SCHED;
            PG8_LDB(B1, 0, 1); PG8_STAGE(PG8_SB(0, 0), b2, voffB);
            PG8_BAR; PG8_WAIT_L(0); PG8_MMA(0, 1, At, B1); PG8_BAR;
            PG8_LDA(At, 0, 1); PG8_STAGE(PG8_SA(0, 0), a2, voffA);
            PG8_BAR; PG8_WAIT_L(0); PG8_MMA(1, 0, At, B0); PG8_BAR; PG8_SCHED;
            PG8_STAGE(PG8_SB(0, 1), b2 + hstep, voffB);
            PG8_WAIT_V(6); PG8_BAR; PG8_MMA(1, 1, At, B1); PG8_BAR;
            PG8_LDB(B0, 1, 0); PG8_SCHED; PG8_LDA(At, 1, 0); PG8_STAGE(PG8_SA(0, 1), a2 + hstep, voffA);
            PG8_WAIT_L(8); PG8_BAR; PG8_WAIT_L(0); PG8_MMA(0, 0, At, B0); PG8_BAR; PG8_SCHED;
            PG8_LDB(B1, 1, 1); PG8_STAGE(PG8_SB(1, 0), b3, voffB);
            PG8_BAR; PG8_WAIT_L(0); PG8_MMA(0, 1, At, B1); PG8_BAR;
            PG8_LDA(At, 1, 1); PG8_STAGE(PG8_SA(1, 0), a3, voffA);
            PG8_BAR; PG8_WAIT_L(0); PG8_MMA(1, 0, At, B0); PG8_BAR; PG8_SCHED;
            PG8_STAGE(PG8_SB(1, 1), b3 + hstep, voffB);
            PG8_WAIT_V(6); PG8_BAR; PG8_MMA(1, 1, At, B1); PG8_BAR;
            }
        }
        if constexpr (ALIGN_EPI) { if (wr == 0) PG8_BAR; }
        E(acc, cur, wr, wc, fr, fq);
        if (!has_next) break;
#pragma unroll
        for (int a = 0; a < 2; ++a)
#pragma unroll
            for (int b = 0; b < 2; ++b)
#pragma unroll
                for (int m = 0; m < 4; ++m)
#pragma unroll
                    for (int n = 0; n < 2; ++n) acc[a][b][m][n] = (f32x4){0.f, 0.f, 0.f, 0.f};
        cur = nxt; cA = nA; cB = nB; ++ui;
        if constexpr (ALIGN_EPI) { if (wr == 1) PG8_BAR; }
    }
    PG8_WAIT_V(0);
    if constexpr (!ALIGN_EPI) { if (wr == 0) PG8_BAR; }
    PG8_BAR;
#undef PG8_APTR
#undef PG8_SA
#undef PG8_SB
#undef PG8_STAGE
#undef PG8_LDA
#undef PG8_LDB
#undef PG8_MMA
#undef PG8_WAIT_V
#undef PG8_WAIT_L
#undef PG8_BAR
#undef PG8_SCHED
}
}

__device__ void phase_p0(const Args& a, LAS unsigned char* lds) {
    const int tid = ltid();
    float* mod = (float*)(a.ws + WS_MOD);
    for (int it = lbid(); it < 192; it += gridDim.x) {
        LAS float* sS = (LAS float*)lds; LAS float* red = sS + 9 * 1024;
        for (int e = tid; e < 9 * 1024; e += NT) { const int i = e >> 10, k = e & 1023; const float v = (i < 8) ? a.c[i * 1024 + k] : a.c_ctx[k]; sS[e] = silu(v); }
        __syncthreads();
        const int col = tid & 31, ks = tid >> 5, j = it * 32 + col;
        float acc[9];
#pragma unroll
        for (int i = 0; i < 9; ++i) acc[i] = 0.f;
#pragma unroll 1
        for (int k8 = 0; k8 < 64; k8 += 16) { float w[16];
#pragma unroll
            for (int kk = 0; kk < 16; ++kk) w[kk] = a.w_mod[(size_t)(ks * 64 + k8 + kk) * 6144 + j];
#pragma unroll
            for (int kk = 0; kk < 16; ++kk) { const int k = ks * 64 + k8 + kk;
#pragma unroll
                for (int i = 0; i < 9; ++i) acc[i] += sS[i * 1024 + k] * w[kk]; } }
#pragma unroll
        for (int i = 0; i < 9; ++i) red[(ks * 9 + i) * 32 + col] = acc[i];
        __syncthreads();
        if (tid < 288) { const int i = tid >> 5, cc = tid & 31; float s = 0.f; for (int q = 0; q < 16; ++q) s += red[(q * 9 + i) * 32 + cc]; mod[i * 6144 + it * 32 + cc] = s + a.b_mod[it * 32 + cc]; }
        __syncthreads();
    }
    LAS float* tile = (LAS float*)lds;
    auto decode = [&](int tt, const float*& src, bf16_t*& dst, int& K, int& Ns, int& kt, int& ntl, int& scol) {
        if (tt < 1152) { src = a.w_in; dst = (bf16_t*)(a.ws + WS_WIN); K = 1024; Ns = 4624; kt = tt & 15; ntl = tt >> 4; scol = ntl * 64; if (scol >= 2048) scol += 16; }
        else if (tt < 1408) { const int u = tt - 1152; src = a.w_out; dst = (bf16_t*)(a.ws + WS_WOUT); K = 1024; Ns = 1024; kt = u & 15; ntl = u >> 4; scol = ntl * 64; }
        else if (tt < 2816) { const int u = tt - 1408; src = a.w_up; dst = (bf16_t*)(a.ws + WS_WUP); K = 1024; Ns = 5632; kt = u & 15; ntl = u >> 4; scol = ntl * 64; }
        else { const int u = tt - 2816; src = a.w_down; dst = (bf16_t*)(a.ws + WS_WDN); K = 2816; Ns = 1024; kt = u % 44; ntl = u / 44; scol = ntl * 64; } };
    const int tkk = tid >> 4, tn4 = (tid & 15) * 4;
    auto ldtile = [&](int tt, f32x4& v0, f32x4& v1) { const float* src; bf16_t* dst; int K, Ns, kt, ntl, scol; decode(tt, src, dst, K, Ns, kt, ntl, scol);
        v0 = *(const f32x4*)(src + (size_t)(kt * 64 + tkk) * Ns + scol + tn4); v1 = *(const f32x4*)(src + (size_t)(kt * 64 + tkk + 32) * Ns + scol + tn4); };
    f32x4 c0, c1, n0, n1; int tt = lbid();
    if (tt < 3520) ldtile(tt, c0, c1);
    for (; tt < 3520; tt += gridDim.x) {
        const int tnx = tt + gridDim.x; if (tnx < 3520) ldtile(tnx, n0, n1);
        const float* src; bf16_t* dst; int K, Ns, kt, ntl, scol; decode(tt, src, dst, K, Ns, kt, ntl, scol);
        tile[tkk * 65 + tn4] = c0[0]; tile[tkk * 65 + tn4 + 1] = c0[1]; tile[tkk * 65 + tn4 + 2] = c0[2]; tile[tkk * 65 + tn4 + 3] = c0[3];
        tile[(tkk + 32) * 65 + tn4] = c1[0]; tile[(tkk + 32) * 65 + tn4 + 1] = c1[1]; tile[(tkk + 32) * 65 + tn4 + 2] = c1[2]; tile[(tkk + 32) * 65 + tn4 + 3] = c1[3];
        __syncthreads();
        { const int n = tid >> 3, k8 = (tid & 7) * 8; u32x4 w;
          w.x = pack2(tile[(k8 + 0) * 65 + n], tile[(k8 + 1) * 65 + n]); w.y = pack2(tile[(k8 + 2) * 65 + n], tile[(k8 + 3) * 65 + n]);
          w.z = pack2(tile[(k8 + 4) * 65 + n], tile[(k8 + 5) * 65 + n]); w.w = pack2(tile[(k8 + 6) * 65 + n], tile[(k8 + 7) * 65 + n]);
          *(u32x4*)(dst + (size_t)(ntl * 64 + n) * K + kt * 64 + k8) = w; }
        __syncthreads();
        c0 = n0; c1 = n1;
    }
}

__device__ void phase_p1(const Args& a, LAS unsigned char* lds) {
    const int tid = ltid(), lane = tid & 63, wave = tid >> 6;
    LAS float* wgT = (LAS float*)lds;
    for (int e = tid; e < 16384; e += NT) { const int k = e >> 4, j = e & 15; wgT[j * 1024 + k] = a.w_in[(size_t)k * 4624 + 2048 + j]; }
    __syncthreads();
    const float* mod = (const float*)(a.ws + WS_MOD);
    bf16_t* A1 = (bf16_t*)(a.ws + WS_R1);
    float* gates = (float*)(a.ws + WS_GATES);
    const int rstep = gridDim.x * 8;
    for (int row0 = lbid() * 8 + wave; row0 < NROWS; row0 += 2 * rstep) {
        const int row1r = row0 + rstep; const bool has1 = row1r < NROWS; const int row1 = has1 ? row1r : row0;
        const float* src0 = row0 < NLAT ? a.x + (size_t)row0 * 1024 : a.ctx + (size_t)(row0 - NLAT) * 1024;
        const float* src1 = row1 < NLAT ? a.x + (size_t)row1 * 1024 : a.ctx + (size_t)(row1 - NLAT) * 1024;
        const float* mb0 = mod + (row0 < NLAT ? (row0 >> 12) : 8) * 6144; const float* mb1 = mod + (row1 < NLAT ? (row1 >> 12) : 8) * 6144;
        float ss0 = 0.f, ss1 = 0.f;
#pragma unroll
        for (int i = 0; i < 8; ++i) { const f32x2 x0 = *(const f32x2*)(src0 + i * 128 + lane * 2), x1 = *(const f32x2*)(src1 + i * 128 + lane * 2); ss0 += x0.x * x0.x + x0.y * x0.y; ss1 += x1.x * x1.x + x1.y * x1.y; }
        ss0 = wsum(ss0); ss1 = wsum(ss1);
        const float rs0 = rsqrtf(ss0 * (1.f / 1024.f) + 1e-6f), rs1 = rsqrtf(ss1 * (1.f / 1024.f) + 1e-6f);
        float g0[16], g1[16];
#pragma unroll
        for (int j = 0; j < 16; ++j) { g0[j] = 0.f; g1[j] = 0.f; }
        f32x2 xv0 = *(const f32x2*)(src0 + lane * 2), xv1 = *(const f32x2*)(src1 + lane * 2), nw = *(const f32x2*)(a.norm1_w + lane * 2);
        f32x2 sh0 = *(const f32x2*)(mb0 + lane * 2), sc0 = *(const f32x2*)(mb0 + 1024 + lane * 2), sh1 = *(const f32x2*)(mb1 + lane * 2), sc1 = *(const f32x2*)(mb1 + 1024 + lane * 2);
#pragma unroll 1
        for (int i = 0; i < 8; ++i) { const int k = i * 128 + lane * 2; const int kn = ((i + 1) & 7) * 128 + lane * 2;
            const f32x2 xn0 = *(const f32x2*)(src0 + kn), xn1 = *(const f32x2*)(src1 + kn), nwn = *(const f32x2*)(a.norm1_w + kn);
            const f32x2 shn0 = *(const f32x2*)(mb0 + kn), scn0 = *(const f32x2*)(mb0 + 1024 + kn), shn1 = *(const f32x2*)(mb1 + kn), scn1 = *(const f32x2*)(mb1 + 1024 + kn);
            const float a00 = xv0.x * rs0 * nw.x * (1.f + sc0.x) + sh0.x, a01 = xv0.y * rs0 * nw.y * (1.f + sc0.y) + sh0.y;
            const float a10 = xv1.x * rs1 * nw.x * (1.f + sc1.x) + sh1.x, a11 = xv1.y * rs1 * nw.y * (1.f + sc1.y) + sh1.y;
            *(unsigned*)(A1 + (size_t)row0 * 1024 + k) = pack2(a00, a01);
            if (has1) *(unsigned*)(A1 + (size_t)row1 * 1024 + k) = pack2(a10, a11);
#pragma unroll
            for (int j = 0; j < 16; ++j) { const f32x2 w = *(const LAS f32x2*)(wgT + j * 1024 + k); g0[j] += a00 * w.x + a01 * w.y; g1[j] += a10 * w.x + a11 * w.y; }
            xv0 = xn0; xv1 = xn1; nw = nwn; sh0 = shn0; sc0 = scn0; sh1 = shn1; sc1 = scn1; }
        float out0 = 0.f, out1 = 0.f;
#pragma unroll
        for (int j = 0; j < 16; ++j) { const float s0 = wsum(g0[j]), s1 = wsum(g1[j]); if (lane == j) { out0 = s0; out1 = s1; } }
        if (lane < 16) { gates[(size_t)row0 * 16 + lane] = out0 + a.gate_b[lane]; if (has1) gates[(size_t)row1 * 16 + lane] = out1 + a.gate_b[lane]; }
    }
}

__device__ void phase_n2(const Args& a) {
    const int tid = ltid(), lane = tid & 63, wave = tid >> 6;
    const float* mod = (const float*)(a.ws + WS_MOD);
    bf16_t* A2 = (bf16_t*)(a.ws + WS_A2);
    const int rstep = gridDim.x * 8;
    for (int row0 = lbid() * 8 + wave; row0 < NLAT; row0 += 2 * rstep) {
        f32x4 v[2][4]; float ss[2] = {0.f, 0.f};
#pragma unroll
        for (int q = 0; q < 2; ++q) { const int row = row0 + q * rstep; if (row < NLAT) { const float* src = a.out + (size_t)row * 1024;
#pragma unroll
            for (int i = 0; i < 4; ++i) v[q][i] = *(const f32x4*)(src + i * 256 + lane * 4); } }
#pragma unroll
        for (int q = 0; q < 2; ++q) { const int row = row0 + q * rstep; if (row < NLAT) {
#pragma unroll
            for (int i = 0; i < 4; ++i) ss[q] += v[q][i][0] * v[q][i][0] + v[q][i][1] * v[q][i][1] + v[q][i][2] * v[q][i][2] + v[q][i][3] * v[q][i][3]; } }
        ss[0] = wsum(ss[0]); ss[1] = wsum(ss[1]);
#pragma unroll
        for (int q = 0; q < 2; ++q) { const int row = row0 + q * rstep; if (row < NLAT) { const float rs = rsqrtf(ss[q] * (1.f / 1024.f) + 1e-6f); const float* mb = mod + (row >> 12) * 6144;
#pragma unroll
            for (int i = 0; i < 4; ++i) { const int k = i * 256 + lane * 4;
                const f32x4 nw = *(const f32x4*)(a.norm2_w + k), sh = *(const f32x4*)(mb + 3072 + k), sc = *(const f32x4*)(mb + 4096 + k);
                u32x2 w; w.x = pack2(v[q][i][0] * rs * nw[0] * (1.f + sc[0]) + sh[0], v[q][i][1] * rs * nw[1] * (1.f + sc[1]) + sh[1]);
                w.y = pack2(v[q][i][2] * rs * nw[2] * (1.f + sc[2]) + sh[2], v[q][i][3] * rs * nw[3] * (1.f + sc[3]) + sh[3]);
                *(u32x2*)(A2 + (size_t)row * 1024 + k) = w; } } }
    }
}
__device__ void phase_fn(const Args& a) {
    const int tid = ltid(), lane = tid & 63, wave = tid >> 6;
    const int rstep = gridDim.x * 8;
    f32x4 nw[4];
#pragma unroll
    for (int i = 0; i < 4; ++i) nw[i] = *(const f32x4*)(a.final_w + i * 256 + lane * 4);
    for (int row0 = lbid() * 8 + wave; row0 < NLAT; row0 += 2 * rstep) {
        f32x4 v[2][4]; float ss[2] = {0.f, 0.f};
#pragma unroll
        for (int q = 0; q < 2; ++q) { const int row = row0 + q * rstep; if (row < NLAT) { const float* src = a.out + (size_t)row * 1024;
#pragma unroll
            for (int i = 0; i < 4; ++i) v[q][i] = *(const f32x4*)(src + i * 256 + lane * 4); } }
#pragma unroll
        for (int q = 0; q < 2; ++q) { const int row = row0 + q * rstep; if (row < NLAT) {
#pragma unroll
            for (int i = 0; i < 4; ++i) ss[q] += v[q][i][0] * v[q][i][0] + v[q][i][1] * v[q][i][1] + v[q][i][2] * v[q][i][2] + v[q][i][3] * v[q][i][3]; } }
        ss[0] = wsum(ss[0]); ss[1] = wsum(ss[1]);
#pragma unroll
        for (int q = 0; q < 2; ++q) { const int row = row0 + q * rstep; if (row < NLAT) { const float rs = rsqrtf(ss[q] * (1.f / 1024.f) + 1e-6f); float* dst = a.out + (size_t)row * 1024;
#pragma unroll
            for (int i = 0; i < 4; ++i) *(f32x4*)(dst + i * 256 + lane * 4) = v[q][i] * rs * nw[i]; } }
    }
}

__device__ void phase_mc(const Args& a) {
    const int tid = ltid(), cgi = tid & 127, seg = tid >> 7, c0 = cgi * 8;
    const bf16_t* P = (const bf16_t*)(a.ws + WS_P); bf16_t* QK = (bf16_t*)(a.ws + WS_R1);
    float w[9][8];
#pragma unroll
    for (int t = 0; t < 9; ++t) { const f32x4 w0 = *(const f32x4*)(a.ml_conv_w + t * 1024 + c0), w1 = *(const f32x4*)(a.ml_conv_w + t * 1024 + c0 + 4);
        w[t][0] = w0[0]; w[t][1] = w0[1]; w[t][2] = w0[2]; w[t][3] = w0[3]; w[t][4] = w1[0]; w[t][5] = w1[1]; w[t][6] = w1[2]; w[t][7] = w1[3]; }
    const float qs = (c0 < 512) ? 0.08838834764831845f : 1.f;
    for (int it = lbid(); it < 640; it += gridDim.x) {
        int rowbase, W, H, y0, nrows, xb;
        if (it < 512) { const int b = it >> 6; rowbase = b * 4096; W = 64; H = 64; y0 = ((it >> 2) & 15) * 4; nrows = 4; xb = (it & 3) * 16; }
        else { const int ci = it - 512; rowbase = NLAT + (ci >> 4) * 256; W = 256; H = 1; y0 = 0; nrows = 1; xb = (ci & 15) * 16; }
        const int x0 = xb + seg * 4;
        u32x4 r[3][6];
        auto ldrow = [&](int y, u32x4 (&d)[6]) {
            const bool vy = (y >= 0 && y < H);
#pragma unroll
            for (int j = 0; j < 6; ++j) { const int xx = x0 - 1 + j;
                d[j] = (vy && xx >= 0 && xx < W) ? *(const u32x4*)(P + (size_t)(rowbase + y * W + xx) * NPC + c0) : (u32x4){0u, 0u, 0u, 0u}; } };
        ldrow(y0 - 1, r[0]); ldrow(y0, r[1]);
#pragma unroll 1
        for (int ry = 0; ry < nrows; ++ry) { const int y = y0 + ry;
            ldrow(y + 1, r[2]);
#pragma unroll
            for (int xi = 0; xi < 4; ++xi) {
                float acc[8];
#pragma unroll
                for (int e = 0; e < 8; ++e) acc[e] = 0.f;
#pragma unroll
                for (int dy = 0; dy < 3; ++dy)
#pragma unroll
                    for (int dx = 0; dx < 3; ++dx) { const u32x4 d = r[dy][xi + dx]; const int t = dy * 3 + dx;
                        acc[0] += lo_f(d.x) * w[t][0]; acc[1] += hi_f(d.x) * w[t][1]; acc[2] += lo_f(d.y) * w[t][2]; acc[3] += hi_f(d.y) * w[t][3];
                        acc[4] += lo_f(d.z) * w[t][4]; acc[5] += hi_f(d.z) * w[t][5]; acc[6] += lo_f(d.w) * w[t][6]; acc[7] += hi_f(d.w) * w[t][7]; }
                u32x4 o; o.x = pack2(silu(acc[0]) * qs, silu(acc[1]) * qs); o.y = pack2(silu(acc[2]) * qs, silu(acc[3]) * qs);
                o.z = pack2(silu(acc[4]) * qs, silu(acc[5]) * qs); o.w = pack2(silu(acc[6]) * qs, silu(acc[7]) * qs);
                *(u32x4*)(QK + (size_t)(rowbase + y * W + x0 + xi) * 1024 + c0) = o; }
#pragma unroll
            for (int j = 0; j < 6; ++j) { r[0][j] = r[1][j]; r[1][j] = r[2][j]; }
        }
    }
}

__device__ void phase_cv(const Args& a, int b_lo, bf16_t* ACT) {
    const int tid = ltid(), cgl = tid & 31, seg = tid >> 5;
    const bf16_t* U = (const bf16_t*)(a.ws + WS_U);
    for (int it = lbid(); it < 1408; it += gridDim.x) {
        const int cb = it % 22, band = (it / 22) & 15, bb = it / 352;
        const int c = cb * 128 + cgl * 4, y0 = band * 4, x0 = seg * 4;
        float wa[9][4], wb[9][4];
#pragma unroll
        for (int t = 0; t < 9; ++t) { const f32x4 w0 = *(const f32x4*)(a.ffn_conv_w + t * 5632 + c), w1 = *(const f32x4*)(a.ffn_conv_w + t * 5632 + 2816 + c);
            wa[t][0] = w0[0]; wa[t][1] = w0[1]; wa[t][2] = w0[2]; wa[t][3] = w0[3]; wb[t][0] = w1[0]; wb[t][1] = w1[1]; wb[t][2] = w1[2]; wb[t][3] = w1[3]; }
        const size_t rowb = (size_t)(b_lo + bb) * 4096;
        u32x2 ra[3][6], rbv[3][6];
        auto ldrow = [&](int y, u32x2 (&da)[6], u32x2 (&db)[6]) {
            const bool vy = (y >= 0 && y < 64);
#pragma unroll
            for (int j = 0; j < 6; ++j) { const int xx = x0 - 1 + j;
                if (vy && xx >= 0 && xx < 64) { const bf16_t* p = U + (rowb + y * 64 + xx) * 5632 + c; da[j] = *(const u32x2*)p; db[j] = *(const u32x2*)(p + 2816); }
                else { da[j] = (u32x2){0u, 0u}; db[j] = (u32x2){0u, 0u}; } } };
        ldrow(y0 - 1, ra[0], rbv[0]); ldrow(y0, ra[1], rbv[1]);
#pragma unroll
        for (int ry = 0; ry < 4; ++ry) { const int y = y0 + ry;
            ldrow(y + 1, ra[2], rbv[2]);
#pragma unroll
            for (int xi = 0; xi < 4; ++xi) {
                float aa[4] = {0.f, 0.f, 0.f, 0.f}, ab[4] = {0.f, 0.f, 0.f, 0.f};
#pragma unroll
                for (int dy = 0; dy < 3; ++dy)
#pragma unroll
                    for (int dx = 0; dx < 3; ++dx) { const int t = dy * 3 + dx; const u32x2 d = ra[dy][xi + dx], e = rbv[dy][xi + dx];
                        aa[0] += lo_f(d.x) * wa[t][0]; aa[1] += hi_f(d.x) * wa[t][1]; aa[2] += lo_f(d.y) * wa[t][2]; aa[3] += hi_f(d.y) * wa[t][3];
                        ab[0] += lo_f(e.x) * wb[t][0]; ab[1] += hi_f(e.x) * wb[t][1]; ab[2] += lo_f(e.y) * wb[t][2]; ab[3] += hi_f(e.y) * wb[t][3]; }
                u32x2 o; o.x = pack2(silu(aa[0]) * ab[0], silu(aa[1]) * ab[1]); o.y = pack2(silu(aa[2]) * ab[2], silu(aa[3]) * ab[3]);
                *(u32x2*)(ACT + ((size_t)bb * 4096 + y * 64 + x0 + xi) * 2816 + c) = o; }
#pragma unroll
            for (int j = 0; j < 6; ++j) { ra[0][j] = ra[1][j]; ra[1][j] = ra[2][j]; rbv[0][j] = rbv[1][j]; rbv[1][j] = rbv[2][j]; }
        }
    }
}

__device__ __forceinline__ void ml_scan(const LAS float* lf, const LAS float* ig, bool rev, int lane, float (&b)[4], float (&c)[4], float (&gm)[4], float& Btot, float& cmax) {
    float l[4], s = 0.f;
#pragma unroll
    for (int i = 0; i < 4; ++i) { const int p = 4 * lane + i, t = rev ? 255 - p : p; l[i] = lf[t]; s += l[i]; }
    const float incl = wscan_add(s, lane); float run = incl - s; Btot = __shfl(incl, 63);
    float cm = -INFINITY;
#pragma unroll
    for (int i = 0; i < 4; ++i) { const int p = 4 * lane + i, t = rev ? 255 - p : p; run += l[i]; b[i] = run; c[i] = ig[t] - run; cm = fmaxf(cm, c[i]); gm[i] = cm; }
    const float im = wscan_max(cm, lane); float ex = __shfl_up(im, 1); if (lane == 0) ex = -INFINITY;
#pragma unroll
    for (int i = 0; i < 4; ++i) gm[i] = fmaxf(gm[i], ex);
    cmax = __shfl(im, 63);
}

__device__ __forceinline__ void m1_matmul_store(const LAS unsigned char* vT, const LAS unsigned char* kT, bf16_t* dst, int wave, int lane) {
    const int r = lane & 15, kg = lane >> 4;
    f32x4 acc[8];
#pragma unroll
    for (int n = 0; n < 8; ++n) acc[n] = (f32x4){0.f, 0.f, 0.f, 0.f};
    const LAS unsigned char* pa = vT + (wave * 16 + r) * 528 + kg * 16;
    const LAS unsigned char* pb = kT + r * 528 + kg * 16;
#pragma unroll 2
    for (int ks = 0; ks < 8; ++ks) { const bf16x8 av = *(const LAS bf16x8*)(pa + ks * 64);
#pragma unroll
        for (int n = 0; n < 8; ++n) { const bf16x8 bv = *(const LAS bf16x8*)(pb + n * 16 * 528 + ks * 64); acc[n] = MFMA16(av, bv, acc[n]); } }
#pragma unroll
    for (int n = 0; n < 8; ++n)
#pragma unroll
        for (int j = 0; j < 4; ++j) dst[(wave * 16 + kg * 4 + j) * 128 + n * 16 + r] = f2bf(acc[n][j]);
}

__device__ __forceinline__ void load_vT256(const bf16_t* src, int ld, LAS unsigned char* vT, int tid) {
    const int s = tid & 255, half = tid >> 8;
    const bf16_t* p = src + (size_t)s * ld + half * 64;
#pragma unroll
    for (int q = 0; q < 8; ++q) { const u32x4 d = *(const u32x4*)(p + q * 8); const int cb = half * 64 + q * 8;
        LAS bf16_t* o = (LAS bf16_t*)vT + cb * 264 + s;
        o[0] = (bf16_t)(d.x & 0xffff); o[264] = (bf16_t)(d.x >> 16); o[2 * 264] = (bf16_t)(d.y & 0xffff); o[3 * 264] = (bf16_t)(d.y >> 16);
        o[4 * 264] = (bf16_t)(d.z & 0xffff); o[5 * 264] = (bf16_t)(d.z >> 16); o[6 * 264] = (bf16_t)(d.w & 0xffff); o[7 * 264] = (bf16_t)(d.w >> 16); }
}

constexpr int M1_VT = 0, M1_KT = 67584, M1_MISC = 135168;
__device__ void m1_hg_item(const Args& a, LAS unsigned char* lds, int rowbase, int h, int seqF, int slotF, int slotB);

__device__ void phase_m1(const Args& a, LAS unsigned char* lds) {
    const int tid = ltid(), lane = tid & 63, wave = tid >> 6;
    const bf16_t* P = (const bf16_t*)(a.ws + WS_P); const bf16_t* QK = (const bf16_t*)(a.ws + WS_R1);
    const float* gates = (const float*)(a.ws + WS_GATES);
    bf16_t* mlst = (bf16_t*)a.out; bf16_t* hgst = (bf16_t*)a.out + (size_t)1024 * 16384;
    float* ml_n = (float*)(a.ws + WS_SMALL + SM_MLN); float* hg_B = (float*)(a.ws + WS_SMALL + SM_HGB);
    float* ml_mloc = (float*)(a.ws + WS_SMALL + SM_MLOC); float* ml_B = (float*)(a.ws + WS_SMALL + SM_MLB);
    LAS unsigned char* vT = lds + M1_VT; LAS unsigned char* kT = lds + M1_KT;
    LAS float* misc = (LAS float*)(lds + M1_MISC);
    LAS float *lfF = misc, *igF = misc + 256, *lfB = misc + 512, *igB = misc + 768, *wF = misc + 1024, *wB = misc + 1280, *scal = misc + 1536, *nred = misc + 1552;
    const int nblk = gridDim.x, bidx = lbid(); const int nheavy3 = (nblk == 256) ? 64 : 0;
    for (int pass = 0; pass < 2; ++pass) {
      const bool isml = pass == 1; const int qstart = isml ? bidx - nheavy3 : bidx, qstride = isml ? nblk - nheavy3 : nblk, qend = isml ? 544 : 1088;
      if (qstart < 0) continue;
      for (int qq = qstart; qq < qend; qq += qstride) {
        const int q = isml ? qq : (qq >> 1); const int hdir = qq & 1;
        const int b = q / 68, h = (q / 17) & 3, sc = q % 17;
        const int rowbase = sc == 0 ? NLAT + b * 256 : b * 4096 + (sc - 1) * 256;
        int slotF = sc <= 15 ? sc : -1, slotB = sc == 0 ? 0 : (sc >= 2 ? 17 - sc : -1);
        if (!isml) { if (hdir) slotF = -1; else slotB = -1; if (slotF < 0 && slotB < 0) continue; }
        const int seqF = (b * 4 + h) * 2, seqB = seqF + 1;
        __syncthreads();
        if (isml) {
            if (tid < 256) { const float* g = gates + (size_t)(rowbase + tid) * 16; igF[tid] = g[h]; lfF[tid] = logsig(g[4 + h]); igB[tid] = g[8 + h]; lfB[tid] = logsig(g[12 + h]); }
            load_vT256(P + (size_t)rowbase * NPC + 1024 + h * 128, NPC, vT, tid);
            __syncthreads();
            if (wave < 2) { float bb[4], cc[4], gm[4], Bt, cmx; const bool rev = wave == 1;
                ml_scan(rev ? lfB : lfF, rev ? igB : igF, rev, lane, bb, cc, gm, Bt, cmx);
                LAS float* wd = rev ? wB : wF;
#pragma unroll
                for (int i = 0; i < 4; ++i) { const int p = 4 * lane + i, t = rev ? 255 - p : p; wd[t] = __expf(cc[i] - cmx); }
                if (lane == 0) { scal[wave * 2] = Bt + cmx; scal[wave * 2 + 1] = Bt; } }
            const int s = tid & 255, half = tid >> 8;
            u32x4 kr[8];
            { const bf16_t* p = QK + (size_t)(rowbase + s) * 1024 + 512 + h * 128 + half * 64;
#pragma unroll
              for (int qq = 0; qq < 8; ++qq) kr[qq] = *(const u32x4*)(p + qq * 8); }
            __syncthreads();
#pragma unroll
            for (int dir = 0; dir < 2; ++dir) {
                const int slot = dir ? slotB : slotF; const int seq = dir ? seqB : seqF;
                if (slot >= 0) {
                    const float wv = dir ? wB[s] : wF[s];
#pragma unroll
                    for (int qq = 0; qq < 8; ++qq) { const u32x4 d = kr[qq]; LAS bf16_t* o = (LAS bf16_t*)kT + (half * 64 + qq * 8) * 264 + s;
                        o[0] = f2bf(lo_f(d.x) * wv); o[264] = f2bf(hi_f(d.x) * wv); o[2 * 264] = f2bf(lo_f(d.y) * wv); o[3 * 264] = f2bf(hi_f(d.y) * wv);
                        o[4 * 264] = f2bf(lo_f(d.z) * wv); o[5 * 264] = f2bf(hi_f(d.z) * wv); o[6 * 264] = f2bf(lo_f(d.w) * wv); o[7 * 264] = f2bf(hi_f(d.w) * wv); }
                    __syncthreads();
                    m1_matmul_store(vT, kT, mlst + (size_t)(seq * 16 + slot) * 16384, wave, lane);
                    { const int dk = tid & 127, part = tid >> 7; float sm = 0.f; const LAS bf16_t* kp = (const LAS bf16_t*)kT + dk * 264 + part * 64;
                      for (int e = 0; e < 64; ++e) sm += bf2f(kp[e]);
                      nred[part * 128 + dk] = sm; }
                    __syncthreads();
                    if (tid < 128) ml_n[(size_t)(seq * 16 + slot) * 128 + tid] = nred[tid] + nred[128 + tid] + nred[256 + tid] + nred[384 + tid];
                    if (tid == 0) { ml_mloc[seq * 16 + slot] = scal[dir * 2]; ml_B[seq * 16 + slot] = scal[dir * 2 + 1]; }
                }
            }
        } else {
            m1_hg_item(a, lds, rowbase, h, seqF, slotF, slotB);
        }
    }
  }
}

__device__ void phase_m2(const Args& a) {
    bf16_t* mlst = (bf16_t*)a.out; bf16_t* hgst = (bf16_t*)a.out + (size_t)1024 * 16384;
    float* ml_n = (float*)(a.ws + WS_SMALL + SM_MLN); const float* hg_B = (const float*)(a.ws + WS_SMALL + SM_HGB);
    const float* ml_mloc = (const float*)(a.ws + WS_SMALL + SM_MLOC); const float* ml_B = (const float*)(a.ws + WS_SMALL + SM_MLB); float* ml_mpre = (float*)(a.ws + WS_SMALL + SM_MPRE);
    const int gtid = lbid() * NT + ltid(), gn = gridDim.x * NT;
    for (int g = gtid; g < 64 * 2048; g += gn) {
        const int seq = g >> 11, ch = g & 2047;
        bf16_t* base = mlst + (size_t)seq * 16 * 16384 + ch * 8;
        float m = ml_mloc[seq * 16]; float C[8];
        { const u32x4 d = *(const u32x4*)base; C[0] = lo_f(d.x); C[1] = hi_f(d.x); C[2] = lo_f(d.y); C[3] = hi_f(d.y); C[4] = lo_f(d.z); C[5] = hi_f(d.z); C[6] = lo_f(d.w); C[7] = hi_f(d.w); }
        if (ch == 0) ml_mpre[seq * 16] = m;
        u32x4 dall[16];
#pragma unroll
        for (int p = 1; p < 16; ++p) dall[p] = *(const u32x4*)(base + (size_t)p * 16384);
#pragma unroll
        for (int p = 1; p < 16; ++p) { const float ml = ml_mloc[seq * 16 + p], B = ml_B[seq * 16 + p]; const float mn = fmaxf(B + m, ml); const float fa = __expf(B + m - mn), fb = __expf(ml - mn);
            const u32x4 d = dall[p];
            C[0] = fa * C[0] + fb * lo_f(d.x); C[1] = fa * C[1] + fb * hi_f(d.x); C[2] = fa * C[2] + fb * lo_f(d.y); C[3] = fa * C[3] + fb * hi_f(d.y);
            C[4] = fa * C[4] + fb * lo_f(d.z); C[5] = fa * C[5] + fb * hi_f(d.z); C[6] = fa * C[6] + fb * lo_f(d.w); C[7] = fa * C[7] + fb * hi_f(d.w);
            u32x4 o; o.x = pack2(C[0], C[1]); o.y = pack2(C[2], C[3]); o.z = pack2(C[4], C[5]); o.w = pack2(C[6], C[7]);
            *(u32x4*)(base + (size_t)p * 16384) = o; m = mn; if (ch == 0) ml_mpre[seq * 16 + p] = m; }
    }
    for (int g = gtid; g < 64 * 128; g += gn) {
        const int seq = g >> 7, dk = g & 127; float* base = ml_n + (size_t)seq * 16 * 128 + dk;
        float m = ml_mloc[seq * 16], n = base[0];
        for (int p = 1; p < 16; ++p) { const float ml = ml_mloc[seq * 16 + p], B = ml_B[seq * 16 + p]; const float mn = fmaxf(B + m, ml);
            n = __expf(B + m - mn) * n + __expf(ml - mn) * base[p * 128]; base[p * 128] = n; m = mn; }
    }
    for (int g = gtid; g < 64 * 2048; g += gn) {
        const int seq = g >> 11, ch = g & 2047, dk0 = (ch * 8) & 127;
        bf16_t* base = hgst + (size_t)seq * 16 * 16384 + ch * 8;
        float C[8];
        { const u32x4 d = *(const u32x4*)base; C[0] = lo_f(d.x); C[1] = hi_f(d.x); C[2] = lo_f(d.y); C[3] = hi_f(d.y); C[4] = lo_f(d.z); C[5] = hi_f(d.z); C[6] = lo_f(d.w); C[7] = hi_f(d.w); }
        u32x4 dall[16];
#pragma unroll
        for (int p = 1; p < 16; ++p) dall[p] = *(const u32x4*)(base + (size_t)p * 16384);
#pragma unroll
        for (int p = 1; p < 16; ++p) { const float* bp = hg_B + (size_t)(seq * 16 + p) * 128 + dk0; const f32x4 b0 = *(const f32x4*)bp, b1 = *(const f32x4*)(bp + 4);
            const u32x4 d = dall[p];
            C[0] = __expf(b0[0]) * C[0] + lo_f(d.x); C[1] = __expf(b0[1]) * C[1] + hi_f(d.x); C[2] = __expf(b0[2]) * C[2] + lo_f(d.y); C[3] = __expf(b0[3]) * C[3] + hi_f(d.y);
            C[4] = __expf(b1[0]) * C[4] + lo_f(d.z); C[5] = __expf(b1[1]) * C[5] + hi_f(d.z); C[6] = __expf(b1[2]) * C[6] + lo_f(d.w); C[7] = __expf(b1[3]) * C[7] + hi_f(d.w);
            u32x4 o; o.x = pack2(C[0], C[1]); o.y = pack2(C[2], C[3]); o.z = pack2(C[4], C[5]); o.w = pack2(C[6], C[7]);
            *(u32x4*)(base + (size_t)p * 16384) = o; }
    }
}

constexpr int HG_Q1 = 0, HG_K1 = 17408, HG_KST = 34816, HG_VT = 53248, HG_PB = 71680, HG_ST = 80896, HG_MISC = 115712;

struct StageRegs { u32x4 a0, a1, b0, b1, v0, v1; float g0, g1; };
template <int DIR, bool OUT>
__device__ __forceinline__ void hg_fetch(const Args& a, int rb, int h, StageRegs& R) {
    const int tid = ltid(); const bf16_t* P = (const bf16_t*)(a.ws + WS_P);
    const int s = tid >> 3, sg8 = tid & 7; const bf16_t* rp = P + (size_t)(rb + s) * NPC + h * 128 + sg8 * 16;
    R.a0 = *(const u32x4*)(rp + 2560 + DIR * 512); R.a1 = *(const u32x4*)(rp + 2560 + DIR * 512 + 8);
    if (OUT) { R.b0 = *(const u32x4*)(rp + 2048); R.b1 = *(const u32x4*)(rp + 2048 + 8); }
    const int s2 = tid & 63, cp = tid >> 6; const bf16_t* vp = P + (size_t)(rb + s2) * NPC + 3584 + h * 128 + cp * 16;
    R.v0 = *(const u32x4*)vp; R.v1 = *(const u32x4*)(vp + 8);
}
__device__ __forceinline__ void stage_vT64(LAS unsigned char* lds, int tid, const u32x4& d0, const u32x4& d1) {
    const int s2 = tid & 63, cp = tid >> 6;
#pragma unroll
    for (int qq = 0; qq < 2; ++qq) { const u32x4 d = qq ? d1 : d0; LAS bf16_t* o = (LAS bf16_t*)(lds + HG_VT) + (cp * 16 + qq * 8) * 72 + s2;
        o[0] = (bf16_t)(d.x & 0xffff); o[72] = (bf16_t)(d.x >> 16); o[2 * 72] = (bf16_t)(d.y & 0xffff); o[3 * 72] = (bf16_t)(d.y >> 16);
        o[4 * 72] = (bf16_t)(d.z & 0xffff); o[5 * 72] = (bf16_t)(d.z >> 16); o[6 * 72] = (bf16_t)(d.w & 0xffff); o[7 * 72] = (bf16_t)(d.w >> 16); }
}
template <int DIR, bool OUT>
__device__ __forceinline__ void hg_sub(const Args& a, LAS unsigned char* lds, int rbn, int h, float lb, f32x4 (&st)[8], f32x4 (&oacc)[4], float& bLsum, StageRegs& R) {
    int tid = ltid();
    const int lane = tid & 63, wave = tid >> 6, r = lane & 15, kg = lane >> 4;
    LAS float* misc = (LAS float*)(lds + HG_MISC); LAS float* psum = misc; LAS float* eBL = misc + 512;
    { const int s = tid >> 3, sg8 = tid & 7;
      *(LAS u32x4*)(lds + HG_K1 + s * 272 + sg8 * 32) = R.a0; *(LAS u32x4*)(lds + HG_K1 + s * 272 + sg8 * 32 + 16) = R.a1;
      if (OUT) { *(LAS u32x4*)(lds + HG_Q1 + s * 272 + sg8 * 32) = R.b0; *(LAS u32x4*)(lds + HG_Q1 + s * 272 + sg8 * 32 + 16) = R.b1; }
      stage_vT64(lds, tid, R.v0, R.v1);
      if (rbn >= 0) hg_fetch<DIR, OUT>(a, rbn, h, R); }
    __syncthreads();
    { const int c = tid & 127, part = tid >> 7;
      float sm = 0.f; float sgv[16], lfv[16];
#pragma unroll
      for (int i = 0; i < 16; ++i) { const int u = part * 16 + i, t = DIR ? 63 - u : u; const float z = bf2f(((const LAS bf16_t*)(lds + HG_K1))[t * 136 + c]); sgv[i] = sigm(z); lfv[i] = __logf(lb + (1.f - lb) * sgv[i]); sm += lfv[i]; }
      psum[part * 128 + c] = sm;
      __syncthreads();
      const float p0 = psum[c], p1 = psum[128 + c], p2 = psum[256 + c], p3 = psum[384 + c];
      const float ref = p0 + p1, bL = p0 + p1 + p2 + p3;
      float run = part == 0 ? 0.f : (part == 1 ? p0 : (part == 2 ? p0 + p1 : p0 + p1 + p2));
      if (part == 0) eBL[c] = __expf(bL);
      bLsum += bL;
      const float ebr = __expf(bL - ref);
#pragma unroll
      for (int i = 0; i < 16; ++i) { const int u = part * 16 + i, t = DIR ? 63 - u : u;
          run += lfv[i]; const float kk = (1.f - lb) * (1.f - sgv[i]);
          if (OUT) { const float qv = bf2f(((const LAS bf16_t*)(lds + HG_Q1))[t * 136 + c]);
              const float er = __expf(run - ref); const float kr = kk * __builtin_amdgcn_rcpf(er);
              ((LAS bf16_t*)(lds + HG_Q1))[t * 136 + c] = f2bf(qv * er);
              ((LAS bf16_t*)(lds + HG_K1))[t * 136 + c] = f2bf(kr);
              ((LAS bf16_t*)(lds + HG_KST))[c * 72 + t] = f2bf(kr * ebr); }
          else ((LAS bf16_t*)(lds + HG_KST))[c * 72 + t] = f2bf(kk * __expf(bL - run)); }
      if (OUT) {
#pragma unroll
          for (int n = 0; n < 8; ++n) { const int dk = n * 16 + r; const float e = __expf(psum[dk] + psum[128 + dk]);
#pragma unroll
              for (int jj = 0; jj < 4; ++jj) ((LAS bf16_t*)(lds + HG_ST))[(wave * 16 + kg * 4 + jj) * 136 + dk] = f2bf(st[n][jj] * e); } }
    }
    __syncthreads();
    if (OUT) {
        { const int mt = wave >> 1, n0 = (wave & 1) * 2;
          f32x4 s0 = (f32x4){0.f, 0.f, 0.f, 0.f}, s1 = s0;
#pragma unroll
          for (int ks = 0; ks < 4; ++ks) { const bf16x8 av = *(const LAS bf16x8*)(lds + HG_Q1 + (mt * 16 + r) * 272 + ks * 64 + kg * 16);
              const bf16x8 b0 = *(const LAS bf16x8*)(lds + HG_K1 + (n0 * 16 + r) * 272 + ks * 64 + kg * 16), b1 = *(const LAS bf16x8*)(lds + HG_K1 + ((n0 + 1) * 16 + r) * 272 + ks * 64 + kg * 16);
              s0 = MFMA16(av, b0, s0); s1 = MFMA16(av, b1, s1); }
#pragma unroll
          for (int jj = 0; jj < 4; ++jj) { const int t = mt * 16 + kg * 4 + jj; const int sA = n0 * 16 + r, sB = (n0 + 1) * 16 + r;
              const bool kA = DIR ? (sA >= t) : (sA <= t), kB = DIR ? (sB >= t) : (sB <= t);
              ((LAS bf16_t*)(lds + HG_PB))[t * 72 + sA] = kA ? f2bf(s0[jj]) : (bf16_t)0; ((LAS bf16_t*)(lds + HG_PB))[t * 72 + sB] = kB ? f2bf(s1[jj]) : (bf16_t)0; } }
        __syncthreads();
        { const int mt = wave >> 1, nv0 = (wave & 1) * 4;
#pragma unroll
          for (int ks2 = 0; ks2 < 2; ++ks2) { const bf16x8 av = *(const LAS bf16x8*)(lds + HG_PB + (mt * 16 + r) * 144 + ks2 * 64 + kg * 16);
#pragma unroll
              for (int i = 0; i < 4; ++i) { const bf16x8 bv = *(const LAS bf16x8*)(lds + HG_VT + ((nv0 + i) * 16 + r) * 144 + ks2 * 64 + kg * 16); oacc[i] = MFMA16(av, bv, oacc[i]); } }
#pragma unroll
          for (int ks = 0; ks < 4; ++ks) { const bf16x8 av = *(const LAS bf16x8*)(lds + HG_Q1 + (mt * 16 + r) * 272 + ks * 64 + kg * 16);
#pragma unroll
              for (int i = 0; i < 4; ++i) { const bf16x8 bv = *(const LAS bf16x8*)(lds + HG_ST + ((nv0 + i) * 16 + r) * 272 + ks * 64 + kg * 16); oacc[i] = MFMA16(av, bv, oacc[i]); } } }
    }
#pragma unroll
    for (int n = 0; n < 8; ++n) { const float e = eBL[n * 16 + r]; st[n] = st[n] * e; }
#pragma unroll
    for (int ks2 = 0; ks2 < 2; ++ks2) { const bf16x8 av = *(const LAS bf16x8*)(lds + HG_VT + (wave * 16 + r) * 144 + ks2 * 64 + kg * 16);
#pragma unroll
        for (int n = 0; n < 8; ++n) { const bf16x8 bv = *(const LAS bf16x8*)(lds + HG_KST + (n * 16 + r) * 144 + ks2 * 64 + kg * 16); st[n] = MFMA16(av, bv, st[n]); } }
    __syncthreads();
}

__device__ __forceinline__ float hg_lb(const Args& a, int dir, int h, int c) {
    const float l0 = a.lb_logits[(dir * 2 + 0) * 512 + h * 128 + c], l1 = a.lb_logits[(dir * 2 + 1) * 512 + h * 128 + c]; return __builtin_amdgcn_rcpf(1.f + __expf(l1 - l0)); }

__device__ void m1_hg_item(const Args& a, LAS unsigned char* lds, int rowbase, int h, int seqF, int slotF, int slotB) {
    const int tid = ltid(), lane = tid & 63, wave = tid >> 6, r = lane & 15, kg = lane >> 4, c = tid & 127;
    bf16_t* hgst = (bf16_t*)a.out + (size_t)1024 * 16384; float* hg_B = (float*)(a.ws + WS_SMALL + SM_HGB);
    f32x4 dummy[4]; f32x4 st[8]; StageRegs R;
    __syncthreads();
    if (slotF >= 0) {
        const float lb = hg_lb(a, 0, h, c); float bs = 0.f;
#pragma unroll
        for (int n = 0; n < 8; ++n) st[n] = (f32x4){0.f, 0.f, 0.f, 0.f};
        hg_fetch<0, false>(a, rowbase, h, R);
#pragma unroll 1
        for (int scu = 0; scu < 4; ++scu) hg_sub<0, false>(a, lds, scu < 3 ? rowbase + (scu + 1) * 64 : -1, h, lb, st, dummy, bs, R);
        bf16_t* dst = hgst + (size_t)(seqF * 16 + slotF) * 16384;
#pragma unroll
        for (int n = 0; n < 8; ++n)
#pragma unroll
            for (int jj = 0; jj < 4; ++jj) dst[(wave * 16 + kg * 4 + jj) * 128 + n * 16 + r] = f2bf(st[n][jj]);
        if (tid < 128) hg_B[(size_t)(seqF * 16 + slotF) * 128 + c] = bs;
    }
    if (slotB >= 0) {
        const float lb = hg_lb(a, 1, h, c); float bs = 0.f;
#pragma unroll
        for (int n = 0; n < 8; ++n) st[n] = (f32x4){0.f, 0.f, 0.f, 0.f};
        hg_fetch<1, false>(a, rowbase + 192, h, R);
#pragma unroll 1
        for (int scu = 0; scu < 4; ++scu) hg_sub<1, false>(a, lds, scu < 3 ? rowbase + (2 - scu) * 64 : -1, h, lb, st, dummy, bs, R);
        bf16_t* dst = hgst + (size_t)((seqF + 1) * 16 + slotB) * 16384;
#pragma unroll
        for (int n = 0; n < 8; ++n)
#pragma unroll
            for (int jj = 0; jj < 4; ++jj) dst[(wave * 16 + kg * 4 + jj) * 128 + n * 16 + r] = f2bf(st[n][jj]);
        if (tid < 128) hg_B[(size_t)((seqF + 1) * 16 + slotB) * 128 + c] = bs;
    }
}

__device__ void m3_hg_item(const Args& a, LAS unsigned char* lds, int q) {
    const int tid = ltid(), lane = tid & 63, wave = tid >> 6, r = lane & 15, kg = lane >> 4;
    const int b = q >> 6, h = (q >> 4) & 3, j = (q & 15) + 1;
    const int rowbase = b * 4096 + (j - 1) * 256;
    const bf16_t* P = (const bf16_t*)(a.ws + WS_P);
    const bf16_t* hgst = (const bf16_t*)a.out + (size_t)1024 * 16384;
    bf16_t* Y = (bf16_t*)(a.ws + WS_Y);
    const int seqF = (b * 4 + h) * 2, seqB = seqF + 1;
    const int slF = seqF * 16 + (j - 1), slB = seqB * 16 + (16 - j);
    const int c = tid & 127;
    const int mt = wave >> 1, hv = wave & 1;
    f32x4 st[8]; float bs = 0.f; StageRegs R;
    __syncthreads();
    {
        const float lb = hg_lb(a, 0, h, c);
        hg_fetch<0, true>(a, rowbase, h, R);
        const bf16_t* sp = hgst + (size_t)slF * 16384;
#pragma unroll
        for (int n = 0; n < 8; ++n)
#pragma unroll
            for (int jj = 0; jj < 4; ++jj) st[n][jj] = bf2f(sp[(wave * 16 + kg * 4 + jj) * 128 + n * 16 + r]);
#pragma unroll 1
        for (int scu = 0; scu < 4; ++scu) {
            f32x4 o[4];
#pragma unroll
            for (int i = 0; i < 4; ++i) o[i] = (f32x4){0.f, 0.f, 0.f, 0.f};
            const int rb = rowbase + scu * 64;
            hg_sub<0, true>(a, lds, scu < 3 ? rb + 64 : -1, h, lb, st, o, bs, R);
            { u32x4* pk = (u32x4*)(a.ws + WS_PARK + (size_t)lbid() * 65536) + (scu * NT + tid) * 2;
              pk[0] = (u32x4){pack2(o[0][0], o[0][1]), pack2(o[0][2], o[0][3]), pack2(o[1][0], o[1][1]), pack2(o[1][2], o[1][3])};
              pk[1] = (u32x4){pack2(o[2][0], o[2][1]), pack2(o[2][2], o[2][3]), pack2(o[3][0], o[3][1]), pack2(o[3][2], o[3][3])}; }
        }
    }
    {
        const float lb = hg_lb(a, 1, h, c);
        hg_fetch<1, true>(a, rowbase + 192, h, R);
        const bf16_t* sp = hgst + (size_t)slB * 16384;
        LAS float* ssq = (LAS float*)(lds + HG_MISC) + 1024;
#pragma unroll
        for (int n = 0; n < 8; ++n)
#pragma unroll
            for (int jj = 0; jj < 4; ++jj) st[n][jj] = bf2f(sp[(wave * 16 + kg * 4 + jj) * 128 + n * 16 + r]);
#pragma unroll 1
        for (int scu = 0; scu < 4; ++scu) {
            f32x4 o[4];
#pragma unroll
            for (int i = 0; i < 4; ++i) o[i] = (f32x4){0.f, 0.f, 0.f, 0.f};
            const int rb = rowbase + (3 - scu) * 64;
            hg_sub<1, true>(a, lds, scu < 3 ? rb - 64 : -1, h, lb, st, o, bs, R);
            const u32x4* pkp = (const u32x4*)(a.ws + WS_PARK + (size_t)lbid() * 65536) + ((3 - scu) * NT + tid) * 2; const u32x4 pk0 = pkp[0], pk1 = pkp[1];
#pragma unroll
            for (int jj = 0; jj < 4; ++jj) { float ss = 0.f;
#pragma unroll
                for (int i = 0; i < 4; ++i) { const unsigned pw = (i < 2 ? pk0 : pk1)[(i & 1) * 2 + (jj >> 1)]; const float v = o[i][jj] + ((jj & 1) ? hi_f(pw) : lo_f(pw)); o[i][jj] = v; ss += v * v; }
                ss = red16(ss); if (r == 0) ssq[(mt * 16 + kg * 4 + jj) * 2 + hv] = ss; }
            __syncthreads();
#pragma unroll
            for (int jj = 0; jj < 4; ++jj) { const int t = mt * 16 + kg * 4 + jj; const float rs = rsqrtf((ssq[t * 2] + ssq[t * 2 + 1]) * (1.f / 128.f) + 1e-6f);
#pragma unroll
                for (int i = 0; i < 4; ++i) { const int col = h * 128 + hv * 64 + i * 16 + r; const float g = bf2f(P[(size_t)(rb + t) * NPC + 4096 + col]);
                    Y[(size_t)(rb + t) * 1024 + 512 + col] = f2bf(o[i][jj] * rs * a.hg_norm_w[col] * g); } }
        }
    }
}

template <int DIR>
__device__ __forceinline__ void ml_fetch(const Args& a, int rb, int h, StageRegs& R) {
    const int tid = ltid(); const bf16_t* P = (const bf16_t*)(a.ws + WS_P); const bf16_t* QK = (const bf16_t*)(a.ws + WS_R1); const float* gates = (const float*)(a.ws + WS_GATES);
    const int s = tid >> 3, sg8 = tid & 7; const bf16_t* qp = QK + (size_t)(rb + s) * 1024 + h * 128 + sg8 * 16;
    R.b0 = *(const u32x4*)qp; R.b1 = *(const u32x4*)(qp + 8); R.a0 = *(const u32x4*)(qp + 512); R.a1 = *(const u32x4*)(qp + 520);
    const int s2 = tid & 63, cp = tid >> 6; const bf16_t* vp = P + (size_t)(rb + s2) * NPC + 1024 + h * 128 + cp * 16;
    R.v0 = *(const u32x4*)vp; R.v1 = *(const u32x4*)(vp + 8);
    if (tid < 64) { const float* g = gates + (size_t)(rb + tid) * 16; R.g0 = g[(DIR ? 12 : 4) + h]; R.g1 = g[(DIR ? 8 : 0) + h]; }
}
template <int DIR>
__device__ __forceinline__ void ml_sub(const Args& a, LAS unsigned char* lds, int rbn, int h, f32x4 (&st)[8], f32x4 (&hout)[4], StageRegs& R) {
    const int tid = ltid(), lane = tid & 63, wave = tid >> 6, r = lane & 15, kg = lane >> 4;
    LAS float* mf = (LAS float*)(lds + HG_MISC);
    LAS float *psum = mf, *nS = mf + 512, *lfA = mf + 640, *igA = mf + 704, *cA = mf + 768, *MA = mf + 832, *wiA = mf + 896, *flA = mf + 960, *wsA = mf + 1024, *scal = mf + 1088, *denP = mf + 1104, *qnP = mf + 1232;
    { const int s = tid >> 3, sg8 = tid & 7;
      *(LAS u32x4*)(lds + HG_Q1 + s * 272 + sg8 * 32) = R.b0; *(LAS u32x4*)(lds + HG_Q1 + s * 272 + sg8 * 32 + 16) = R.b1;
      *(LAS u32x4*)(lds + HG_K1 + s * 272 + sg8 * 32) = R.a0; *(LAS u32x4*)(lds + HG_K1 + s * 272 + sg8 * 32 + 16) = R.a1;
      stage_vT64(lds, tid, R.v0, R.v1);
      if (tid < 64) { lfA[tid] = logsig(R.g0); igA[tid] = R.g1; }
      if (rbn >= 0) ml_fetch<DIR>(a, rbn, h, R); }
    __syncthreads();
    if (tid < 64) { const int t = DIR ? 63 - lane : lane;
        const float l = lfA[t], ig = igA[t];
        const float b = wscan_add(l, lane); const float c = ig - b; const float gmx = wscan_max(c, lane);
        const float mprev = scal[1]; const float M = fmaxf(mprev, gmx);
        const float Btot = __shfl(b, 63), cmax = __shfl(gmx, 63); const float Mall = fmaxf(mprev, cmax);
        cA[t] = c; MA[t] = M; wiA[t] = __expf(mprev - M); flA[t] = __expf(-b - M); wsA[t] = __expf(c - Mall);
        if (lane == 0) { scal[0] = __expf(mprev - Mall); scal[2] = Btot + Mall; } }
    __syncthreads();
    { const int mt = wave >> 1, n0 = (wave & 1) * 2;
      f32x4 s0 = (f32x4){0.f, 0.f, 0.f, 0.f}, s1 = s0;
#pragma unroll
      for (int ks = 0; ks < 4; ++ks) { const bf16x8 av = *(const LAS bf16x8*)(lds + HG_Q1 + (mt * 16 + r) * 272 + ks * 64 + kg * 16);
          const bf16x8 b0 = *(const LAS bf16x8*)(lds + HG_K1 + (n0 * 16 + r) * 272 + ks * 64 + kg * 16), b1 = *(const LAS bf16x8*)(lds + HG_K1 + ((n0 + 1) * 16 + r) * 272 + ks * 64 + kg * 16);
          s0 = MFMA16(av, b0, s0); s1 = MFMA16(av, b1, s1); }
      const int sA = n0 * 16 + r, sB = sA + 16; const float cAv = cA[sA], cBv = cA[sB];
#pragma unroll
      for (int jj = 0; jj < 4; ++jj) { const int t = mt * 16 + kg * 4 + jj; const float Mt = MA[t];
          const bool kA = DIR ? (sA >= t) : (sA <= t), kB = DIR ? (sB >= t) : (sB <= t);
          const float pA = kA ? s0[jj] * __expf(cAv - Mt) : 0.f, pB = kB ? s1[jj] * __expf(cBv - Mt) : 0.f;
          ((LAS bf16_t*)(lds + HG_PB))[t * 72 + sA] = f2bf(pA); ((LAS bf16_t*)(lds + HG_PB))[t * 72 + sB] = f2bf(pB);
          const float ds = red16(pA + pB); if (r == 0) denP[t * 2 + (wave & 1)] = ds; } }
    { const int c = tid & 127, part = tid >> 7; float sm = 0.f;
#pragma unroll 4
      for (int i = 0; i < 16; ++i) { const int t = part * 16 + i; const float kw = bf2f(((const LAS bf16_t*)(lds + HG_K1))[t * 136 + c]) * wsA[t];
          ((LAS bf16_t*)(lds + HG_KST))[c * 72 + t] = f2bf(kw); sm += kw; }
      psum[part * 128 + c] = sm; }
    { const int t = tid & 63, p8 = tid >> 6; float acc = 0.f;
#pragma unroll 4
      for (int i = 0; i < 16; ++i) { const int dk = p8 * 16 + i; acc += bf2f(((const LAS bf16_t*)(lds + HG_Q1))[t * 136 + dk]) * nS[dk]; }
      qnP[p8 * 64 + t] = acc; }
#pragma unroll
    for (int n = 0; n < 8; ++n)
#pragma unroll
        for (int jj = 0; jj < 4; ++jj) ((LAS bf16_t*)(lds + HG_ST))[(wave * 16 + kg * 4 + jj) * 136 + n * 16 + r] = f2bf(st[n][jj]);
    __syncthreads();
    { const int mt = wave >> 1, nv0 = (wave & 1) * 4;
      f32x4 o1[4], o2[4];
#pragma unroll
      for (int i = 0; i < 4; ++i) { o1[i] = (f32x4){0.f, 0.f, 0.f, 0.f}; o2[i] = o1[i]; }
#pragma unroll
      for (int ks2 = 0; ks2 < 2; ++ks2) { const bf16x8 av = *(const LAS bf16x8*)(lds + HG_PB + (mt * 16 + r) * 144 + ks2 * 64 + kg * 16);
#pragma unroll
          for (int i = 0; i < 4; ++i) { const bf16x8 bv = *(const LAS bf16x8*)(lds + HG_VT + ((nv0 + i) * 16 + r) * 144 + ks2 * 64 + kg * 16); o1[i] = MFMA16(av, bv, o1[i]); } }
#pragma unroll
      for (int ks = 0; ks < 4; ++ks) { const bf16x8 av = *(const LAS bf16x8*)(lds + HG_Q1 + (mt * 16 + r) * 272 + ks * 64 + kg * 16);
#pragma unroll
          for (int i = 0; i < 4; ++i) { const bf16x8 bv = *(const LAS bf16x8*)(lds + HG_ST + ((nv0 + i) * 16 + r) * 272 + ks * 64 + kg * 16); o2[i] = MFMA16(av, bv, o2[i]); } }
#pragma unroll
      for (int jj = 0; jj < 4; ++jj) { const int t = mt * 16 + kg * 4 + jj; const float wi = wiA[t];
          float qn = 0.f;
#pragma unroll
          for (int p8 = 0; p8 < 8; ++p8) qn += qnP[p8 * 64 + t];
          const float den = denP[t * 2] + denP[t * 2 + 1] + wi * qn; const float inv = __builtin_amdgcn_rcpf(fmaxf(fabsf(den), flA[t]));
#pragma unroll
          for (int i = 0; i < 4; ++i) hout[i][jj] = (o1[i][jj] + wi * o2[i][jj]) * inv; } }
    const float decay = scal[0];
#pragma unroll
    for (int n = 0; n < 8; ++n) st[n] = st[n] * decay;
#pragma unroll
    for (int ks2 = 0; ks2 < 2; ++ks2) { const bf16x8 av = *(const LAS bf16x8*)(lds + HG_VT + (wave * 16 + r) * 144 + ks2 * 64 + kg * 16);
#pragma unroll
        for (int n = 0; n < 8; ++n) { const bf16x8 bv = *(const LAS bf16x8*)(lds + HG_KST + (n * 16 + r) * 144 + ks2 * 64 + kg * 16); st[n] = MFMA16(av, bv, st[n]); } }
    __syncthreads();
    if (tid < 128) nS[tid] = decay * nS[tid] + psum[tid] + psum[128 + tid] + psum[256 + tid] + psum[384 + tid];
    if (tid == 0) scal[1] = scal[2];
}

__device__ void m3_ml2_item(const Args& a, LAS unsigned char* lds, int q) {
    const int tid = ltid(), lane = tid & 63, wave = tid >> 6, r = lane & 15, kg = lane >> 4;
    const int b = q >> 6, h = (q >> 4) & 3, j = (q & 15) + 1;
    const int rowbase = b * 4096 + (j - 1) * 256;
    const bf16_t* P = (const bf16_t*)(a.ws + WS_P);
    const bf16_t* mlst = (const bf16_t*)a.out;
    const float* ml_n = (const float*)(a.ws + WS_SMALL + SM_MLN); const float* ml_mpre = (const float*)(a.ws + WS_SMALL + SM_MPRE);
    bf16_t* Y = (bf16_t*)(a.ws + WS_Y);
    LAS float* mf = (LAS float*)(lds + HG_MISC); LAS float *nS = mf + 512, *scal = mf + 1088, *ssq = mf + 1744;
    const int seqF = (b * 4 + h) * 2, seqB = seqF + 1;
    const int slF = seqF * 16 + (j - 1), slB = seqB * 16 + (16 - j);
    const int mt = wave >> 1, hv = wave & 1;
    f32x4 st[8]; StageRegs R;
    __syncthreads();
    {
        const bf16_t* sp = mlst + (size_t)slF * 16384;
#pragma unroll
        for (int n = 0; n < 8; ++n)
#pragma unroll
            for (int jj = 0; jj < 4; ++jj) st[n][jj] = bf2f(sp[(wave * 16 + kg * 4 + jj) * 128 + n * 16 + r]);
        if (tid < 128) nS[tid] = ml_n[(size_t)slF * 128 + tid];
        if (tid == 0) scal[1] = ml_mpre[slF];
        ml_fetch<0>(a, rowbase, h, R);
#pragma unroll 1
        for (int scu = 0; scu < 4; ++scu) { f32x4 ho[4]; const int rb = rowbase + scu * 64;
            ml_sub<0>(a, lds, scu < 3 ? rb + 64 : -1, h, st, ho, R);
            { u32x4* pk = (u32x4*)(a.ws + WS_PARK + (size_t)lbid() * 65536) + (scu * NT + tid) * 2;
              pk[0] = (u32x4){pack2(ho[0][0], ho[0][1]), pack2(ho[0][2], ho[0][3]), pack2(ho[1][0], ho[1][1]), pack2(ho[1][2], ho[1][3])};
              pk[1] = (u32x4){pack2(ho[2][0], ho[2][1]), pack2(ho[2][2], ho[2][3]), pack2(ho[3][0], ho[3][1]), pack2(ho[3][2], ho[3][3])}; } }
    }
    {
        const bf16_t* sp = mlst + (size_t)slB * 16384;
#pragma unroll
        for (int n = 0; n < 8; ++n)
#pragma unroll
            for (int jj = 0; jj < 4; ++jj) st[n][jj] = bf2f(sp[(wave * 16 + kg * 4 + jj) * 128 + n * 16 + r]);
        if (tid < 128) nS[tid] = ml_n[(size_t)slB * 128 + tid];
        if (tid == 0) scal[1] = ml_mpre[slB];
        ml_fetch<1>(a, rowbase + 192, h, R);
#pragma unroll 1
        for (int scu = 0; scu < 4; ++scu) { f32x4 ho[4]; const int rb = rowbase + (3 - scu) * 64;
            ml_sub<1>(a, lds, scu < 3 ? rb - 64 : -1, h, st, ho, R);
            const u32x4* pkp = (const u32x4*)(a.ws + WS_PARK + (size_t)lbid() * 65536) + ((3 - scu) * NT + tid) * 2; const u32x4 pk0 = pkp[0], pk1 = pkp[1];
#pragma unroll
            for (int jj = 0; jj < 4; ++jj) { float ss = 0.f;
#pragma unroll
                for (int i = 0; i < 4; ++i) { const unsigned pw = (i < 2 ? pk0 : pk1)[(i & 1) * 2 + (jj >> 1)]; const float v = ho[i][jj] + ((jj & 1) ? hi_f(pw) : lo_f(pw)); ho[i][jj] = v; ss += v * v; }
                ss = red16(ss); if (r == 0) ssq[(mt * 16 + kg * 4 + jj) * 2 + hv] = ss; }
            __syncthreads();
#pragma unroll
            for (int jj = 0; jj < 4; ++jj) { const int t = mt * 16 + kg * 4 + jj; const float rs = rsqrtf((ssq[t * 2] + ssq[t * 2 + 1]) * (1.f / 128.f) + 1e-6f);
#pragma unroll
                for (int i = 0; i < 4; ++i) { const int col = h * 128 + hv * 64 + i * 16 + r; const float og = bf2f(P[(size_t)(rb + t) * NPC + 1536 + col]);
                    Y[(size_t)(rb + t) * 1024 + col] = f2bf(ho[i][jj] * rs * a.ml_norm_w[col] * og); } }
        }
    }
}

__device__ void phase_m3(const Args& a, LAS unsigned char* lds) {
    for (int it = lbid(); it < 1024; it += gridDim.x) {
        if (it < 512) m3_ml2_item(a, lds, it); else m3_hg_item(a, lds, it - 512);
    }
}

#define XB_TMO      128
#define XB_XCNT(j)  (256  + 64 * (j))
#define XB_XSUB(j)  (1280 + 64 * (j))
#define XB_XGEN(j)  (2304 + 64 * (j))
#define XB_TOP      3328
#define XB_TOPGEN   3392
#define XCD_BAR_WORDS 3456
#define XB_SPIN_CAP (1u << 18)
__device__ __forceinline__ unsigned xb_ld(unsigned* p)              { return __hip_atomic_load(p, __ATOMIC_RELAXED, __HIP_MEMORY_SCOPE_AGENT); }
__device__ __forceinline__ unsigned xb_add(unsigned* p, unsigned v) { return __hip_atomic_fetch_add(p, v, __ATOMIC_RELAXED, __HIP_MEMORY_SCOPE_AGENT); }
__device__ __forceinline__ unsigned xb_xcc_id() { return (unsigned)__builtin_amdgcn_s_getreg((3 << 11) | 20) & 0xFu; }
#define XB_SPIN(cond, bar) do { unsigned _sp = 0; while (cond) { __builtin_amdgcn_s_sleep(1); \
    if ((++_sp & 255u) == 0u) { if (xb_ld(&(bar)[XB_TMO])) break; if (_sp > XB_SPIN_CAP) { atomicAdd(&(bar)[XB_TMO], 1u); break; } } } } while (0)
struct XcdBarrier { unsigned* bar; unsigned x; volatile LAS unsigned* st; };
__device__ __forceinline__ XcdBarrier xcd_barrier_post(unsigned* bar, volatile LAS unsigned* st) {
    XcdBarrier b; b.bar = bar; b.x = xb_xcc_id(); b.st = st;
    if (threadIdx.x == 0) (void)xb_add(&bar[XB_XCNT(b.x)], 1u);
    return b;
}
__device__ __forceinline__ void xcd_barrier_complete(unsigned* bar, unsigned x, unsigned& nloc, unsigned& nx) {
    const unsigned G = gridDim.x * gridDim.y * gridDim.z;
    unsigned sum, cnt, mine, sp = 0u;
    for (;;) {
        sum = 0u; cnt = 0u; mine = 0u;
#pragma unroll
        for (unsigned j = 0; j < 16; ++j) { const unsigned c = xb_ld(&bar[XB_XCNT(j)]); sum += c; cnt += (c > 0u) ? 1u : 0u; mine = (j == x) ? c : mine; }
        if (sum == G) break;
        __builtin_amdgcn_s_sleep(1);
        if ((++sp & 255u) == 0u) { if (xb_ld(&bar[XB_TMO])) break; if (sp > XB_SPIN_CAP) { atomicAdd(&bar[XB_TMO], 1u); break; } }
    }
    nloc = mine > 0u ? mine : 1u; nx = cnt > 0u ? cnt : 1u;
}
__device__ __forceinline__ void xcd_barrier(const XcdBarrier& b) {
    asm volatile("s_waitcnt vmcnt(0)" ::: "memory");
    __syncthreads();
    if (threadIdx.x == 0) {
        unsigned* bar = b.bar;
        __builtin_amdgcn_s_waitcnt(0);
        unsigned nloc = b.st[0], nx = b.st[1];
        if (nloc == 0u) { xcd_barrier_complete(bar, b.x, nloc, nx); b.st[0] = nloc; b.st[1] = nx; }
        const unsigned old = xb_add(&bar[XB_XSUB(b.x)], 1u);
        const unsigned gen = old / nloc;
        if (old + 1u == (gen + 1u) * nloc) {
            __builtin_amdgcn_fence(__ATOMIC_RELEASE, "agent");
            asm volatile("s_waitcnt vmcnt(0)" ::: "memory");
            const unsigned og = xb_add(&bar[XB_TOP], 1u);
            const unsigned tg = og / nx;
            if (og + 1u == (tg + 1u) * nx) xb_add(&bar[XB_TOPGEN], 1u);
            else XB_SPIN(xb_ld(&bar[XB_TOPGEN]) == tg, bar);
            __builtin_amdgcn_fence(__ATOMIC_ACQUIRE, "agent");
            xb_add(&bar[XB_XGEN(b.x)], 1u);
            asm volatile("s_waitcnt vmcnt(0)" ::: "memory");
        } else {
            XB_SPIN(xb_ld(&bar[XB_XGEN(b.x)]) == gen, bar);
            __builtin_amdgcn_fence(__ATOMIC_ACQUIRE, "agent");
            asm volatile("s_waitcnt vmcnt(0)" ::: "memory");
        }
    }
    __syncthreads();
}
constexpr size_t WS_BAR = WS_SMALL + 1536 * 1024;

constexpr int N_PHASES = 14;
__global__ void __launch_bounds__(NT, 2) mega(Args a) {
    extern __shared__ __attribute__((aligned(16))) unsigned char lds_raw[];
    LAS unsigned char* lds = (LAS unsigned char*)lds_raw;
    cg::grid_group grid = cg::this_grid();
    const int G = gridDim.x, bid = lbid();
    volatile LAS unsigned* stw = (volatile LAS unsigned*)(lds + LDS_BYTES - 16);
    if (threadIdx.x == 0) { stw[0] = 0u; stw[1] = 0u; }
    __syncthreads();
    const XcdBarrier bar = xcd_barrier_post((unsigned*)(a.ws + WS_BAR), stw);
    const int ph_lo = a.ph_lo, ph_hi = a.ph_hi;
    if (ph_lo < 0) grid.sync();
    for (int ph = ph_lo; ph < ph_hi; ++ph) {
        { __attribute__((address_space(1))) unsigned char* w = (__attribute__((address_space(1))) unsigned char*)a.ws; __attribute__((address_space(1))) float* o = (__attribute__((address_space(1))) float*)a.out;
          asm volatile("" : "+s"(w), "+s"(o)); a.ws = (unsigned char*)w; a.out = (float*)o; }
        switch (ph) {
        case 0: phase_p0(a, lds); break;
        case 1: phase_p1(a, lds); break;
        case 2: { pg8::Gemm g{(const bf16_t*)(a.ws + WS_R1), nullptr, 1 << 30, (const bf16_t*)(a.ws + WS_WIN), NROWS, NPC, 1024}; pg8::StaticOrder S; S.init(NROWS, NPC, G, bid);
                  pg8::EpiBf16<true> E{(bf16_t*)(a.ws + WS_P), NPC}; pg8::gemm_phase(lds, g, S, E); } break;
        case 3: phase_mc(a); break;
        case 4: phase_m1(a, lds); break;
        case 5: phase_m2(a); break;
        case 6: phase_m3(a, lds); break;
        case 7: { pg8::Gemm g{(const bf16_t*)(a.ws + WS_Y), nullptr, 1 << 30, (const bf16_t*)(a.ws + WS_WOUT), NLAT, 1024, 1024}; pg8::StaticOrder S; S.init(NLAT, 1024, G, bid);
                  pg8::EpiRes E{a.x, a.out, (const float*)(a.ws + WS_MOD) + 2048}; pg8::gemm_phase(lds, g, S, E); } break;
        case 8: phase_n2(a); break;
        case 9: { pg8::Gemm g{(const bf16_t*)(a.ws + WS_A2), nullptr, 1 << 30, (const bf16_t*)(a.ws + WS_WUP), NLAT, 5632, 1024}; pg8::StaticOrder S; S.init(NLAT, 5632, G, bid);
                  pg8::EpiBf16<false> E{(bf16_t*)(a.ws + WS_U), 5632}; pg8::gemm_phase(lds, g, S, E); } break;
        case 10: phase_cv(a, 0, (bf16_t*)(a.ws + WS_ACTA)); break;
        case 11: phase_cv(a, 4, (bf16_t*)(a.ws + WS_ACTB)); break;
        case 12: { pg8::Gemm g{(const bf16_t*)(a.ws + WS_ACTA), (const bf16_t*)(a.ws + WS_ACTB), 64, (const bf16_t*)(a.ws + WS_WDN), NLAT, 1024, 2816}; pg8::StaticOrder S; S.init(NLAT, 1024, G, bid);
                  pg8::EpiRes E{a.out, a.out, (const float*)(a.ws + WS_MOD) + 5120}; pg8::gemm_phase(lds, g, S, E); } break;
        case 13: phase_fn(a); break;
        }
        if (ph + 1 < ph_hi) xcd_barrier(bar);
    }
}

extern "C" void kernel_launch(void* const* d_in, const int* in_sizes, int n_in, void* d_out, int out_size, void* d_ws, size_t ws_size, hipStream_t stream) {
    static int grid = 0;
    if (grid == 0) {
        if (n_in != 19 || ws_size < WS_NEED) { fprintf(stderr, "kernel_launch: unexpected n_in %d / ws_size %zu\n", n_in, ws_size); grid = -1; return; }
        int dev = 0, cus = 0, per_cu = 0;
        (void)hipGetDevice(&dev); (void)hipDeviceGetAttribute(&cus, hipDeviceAttributeMultiprocessorCount, dev);
        if (hipFuncSetAttribute((const void*)mega, hipFuncAttributeMaxDynamicSharedMemorySize, LDS_BYTES) != hipSuccess) { fprintf(stderr, "kernel_launch: hipFuncSetAttribute failed\n"); grid = -1; return; }
        if (hipOccupancyMaxActiveBlocksPerMultiprocessor(&per_cu, (const void*)mega, NT, LDS_BYTES) != hipSuccess || per_cu < 1) { fprintf(stderr, "kernel_launch: occupancy query says %d\n", per_cu); per_cu = 1; }
        (void)hipGetLastError();
        grid = cus;
    }
    if (grid < 0) return;
    Args a{};
    const float** ip = (const float**)&a;
    for (int i = 0; i < 19; ++i) ip[i] = (const float*)d_in[i];
    a.out = (float*)d_out; a.ws = (unsigned char*)d_ws;
    (void)hipMemsetAsync((unsigned char*)d_ws + WS_BAR, 0, XCD_BAR_WORDS * sizeof(unsigned), stream);
    a.ph_lo = 0; a.ph_hi = N_PHASES; void* args[] = {&a};
    hipError_t e = hipLaunchCooperativeKernel((const void*)mega, dim3(grid), dim3(NT), args, LDS_BYTES, stream);
    if (e != hipSuccess) fprintf(stderr, "cooperative launch failed: %s (grid %d)\n", hipGetErrorString(e), grid);
}
```

```cpp
#include <hip/hip_runtime.h>
#include <hip/hip_cooperative_groups.h>
#include <cstdio>
namespace cg = cooperative_groups;

#define LAS __attribute__((address_space(3)))
typedef unsigned short bf16_t;
typedef short bf16x8 __attribute__((ext_vector_type(8)));
typedef float f32x4 __attribute__((ext_vector_type(4)));
typedef float f32x2 __attribute__((ext_vector_type(2)));
typedef unsigned u32x4 __attribute__((ext_vector_type(4)));
typedef unsigned u32x2 __attribute__((ext_vector_type(2)));


constexpr int NT = 512;
constexpr int LDS_BYTES = 147456;
constexpr size_t MiB = 1048576;
constexpr int NROWS = 34816, NLAT = 32768, NPC = 4608;
constexpr size_t WS_WIN = 0, WS_WOUT = 9 * MiB, WS_WUP = 11 * MiB, WS_WDN = 22 * MiB, WS_MOD = 28 * MiB, WS_GATES = 29 * MiB, WS_SMALL = 32 * MiB;
constexpr size_t WS_R1 = 34 * MiB, WS_P = 102 * MiB, WS_Y = 408 * MiB, WS_U = 34 * MiB, WS_A2 = 448 * MiB, WS_ACTA = 386 * MiB, WS_ACTB = 34 * MiB, WS_NEED = 512 * MiB;
constexpr size_t WS_PARK = 472 * MiB;
constexpr size_t SM_MLN = 0, SM_HGB = 512 * 1024, SM_MLOC = 1024 * 1024, SM_MLB = 1024 * 1024 + 4096, SM_MPRE = 1024 * 1024 + 8192;

struct Args {
    const float *x, *c, *ctx, *c_ctx, *w_mod, *b_mod, *norm1_w, *w_in, *gate_b, *ml_conv_w, *ml_norm_w, *lb_logits, *hg_norm_w, *w_out, *norm2_w, *w_up, *ffn_conv_w, *w_down, *final_w;
    float* out; unsigned char* ws; int ph_lo, ph_hi;
};

__device__ __forceinline__ float bf2f(unsigned short h) { return __uint_as_float(((unsigned)h) << 16); }
typedef __bf16 bf16x2n __attribute__((ext_vector_type(2)));
__device__ __forceinline__ unsigned pack2(float lo, float hi) { const f32x2 v = {lo, hi}; return __builtin_bit_cast(unsigned, __builtin_convertvector(v, bf16x2n)); }
__device__ __forceinline__ unsigned short f2bf(float f) { return (unsigned short)pack2(f, f); }
__device__ __forceinline__ float lo_f(unsigned u) { return __uint_as_float(u << 16); }
__device__ __forceinline__ float hi_f(unsigned u) { return __uint_as_float(u & 0xffff0000u); }
__device__ __forceinline__ float sigm(float x) { return __builtin_amdgcn_rcpf(1.f + __expf(-x)); }
__device__ __forceinline__ float silu(float x) { return x * __builtin_amdgcn_rcpf(1.f + __expf(-x)); }
__device__ __forceinline__ float logsig(float x) { return fminf(x, 0.f) - log1pf(__expf(-fabsf(x))); }
__device__ __forceinline__ float wsum(float v) {
#pragma unroll
    for (int o = 32; o; o >>= 1) v += __shfl_xor(v, o); return v; }
__device__ __forceinline__ float wmaxr(float v) {
#pragma unroll
    for (int o = 32; o; o >>= 1) v = fmaxf(v, __shfl_xor(v, o)); return v; }
__device__ __forceinline__ float wscan_add(float v, int lane) {
#pragma unroll
    for (int o = 1; o < 64; o <<= 1) { float t = __shfl_up(v, o); if (lane >= o) v += t; } return v; }
__device__ __forceinline__ float wscan_max(float v, int lane) {
#pragma unroll
    for (int o = 1; o < 64; o <<= 1) { float t = __shfl_up(v, o); if (lane >= o) v = fmaxf(v, t); } return v; }
__device__ __forceinline__ float red16(float v) { v += __shfl_xor(v, 1); v += __shfl_xor(v, 2); v += __shfl_xor(v, 4); v += __shfl_xor(v, 8); return v; }
__device__ __forceinline__ void wave_lds_sync() { __builtin_amdgcn_fence(__ATOMIC_RELEASE, "workgroup"); __builtin_amdgcn_wave_barrier(); __builtin_amdgcn_fence(__ATOMIC_ACQUIRE, "workgroup"); }
__device__ __forceinline__ int ltid() { int t = threadIdx.x; asm volatile("" : "+v"(t)); return t; }
__device__ __forceinline__ int lbid() { int t = blockIdx.x; asm volatile("" : "+s"(t)); return t; }
#define MFMA16(a, b, c) __builtin_amdgcn_mfma_f32_16x16x32_bf16((a), (b), (c), 0, 0, 0)

namespace pg8 {
constexpr int BM = 256, BK = 64, HALF = 128, HTB = HALF * BK * 2, STAGE_BYTES = 8 * HTB, NXCD = 8, WGM = 4;
__device__ __forceinline__ int lds_byte(int r, int c) { const int st = (r >> 4) * 2 + (c >> 5), rr = r & 15, cc = c & 31, ob = rr * 64 + cc * 2; return st * 1024 + (ob ^ (((ob >> 9) & 1) << 5)); }
__device__ __forceinline__ void stage_rc(int b, int& R, int& C) { const int st = b / 1024, sb = b % 1024, swz = sb ^ (((sb >> 9) & 1) << 5); R = (st >> 1) * 16 + swz / 64; C = (st & 1) * 32 + (swz % 64) / 2; }
__device__ __forceinline__ int perm32(int rho) { const int n = rho >> 4, i = rho & 15; return 8 * (i >> 2) + 4 * n + (i & 3); }
struct Unit { int pm, pn; };
struct Gemm { const bf16_t* A; const bf16_t* A_hi; int pm_split; const bf16_t* Bt; int M, N, K; };
struct StaticOrder {
    int nM, nN, nwg, G, c;
    __device__ void init(int M, int N, int G_, int c_) { nM = M / BM; nN = N / BM; nwg = nM * nN; G = G_; c = c_; }
    __device__ bool next(int i, Unit& u) const {
        const long L = (long)i * G + c; if (L >= nwg) return false;
        int wgid = (int)L; { const int q = nwg / NXCD, r = nwg % NXCD, xcd = wgid % NXCD, off = wgid / NXCD; wgid = (xcd < r ? xcd * (q + 1) : r * (q + 1) + (xcd - r) * q) + off; }
        const int nig = WGM * nN, gid = wgid / nig, fm = gid * WGM, gsz = (nM - fm) < WGM ? (nM - fm) : WGM;
        u.pm = fm + ((wgid % nig) % gsz); u.pn = (wgid % nig) / gsz; return true;
    }
};
__device__ __forceinline__ unsigned cvt_pk_bf16(float lo, float hi) { return pack2(lo, hi); }

template <bool ACT> struct EpiBf16 {
    static constexpr bool PERM = true;
    bf16_t* O; int ldc;
    __device__ __forceinline__ f32x4 act(f32x4 v, int mode) const {
        if (!ACT || mode == 0) return v;
        f32x4 o;
#pragma unroll
        for (int j = 0; j < 4; ++j) { const float s = __builtin_amdgcn_rcpf(1.f + __expf(-v[j])); o[j] = mode == 1 ? s : (mode == 2 ? v[j] * s * 0.08838834764831845f : v[j] * s); }
        return o; }
    __device__ __forceinline__ void operator()(const f32x4 (&acc)[2][2][4][2], const Unit& u, int wr, int wc, int fr, int fq) const {
        const int mode = !ACT ? 0 : ((u.pn == 6 || u.pn == 7) ? 1 : ((u.pn == 8 || u.pn == 9) ? 2 : ((u.pn == 16 || u.pn == 17) ? 3 : 0)));
        const int row0 = u.pm * BM + wr * 64 + fr; const int col0 = u.pn * BM + wc * 32 + 8 * fq;
#pragma unroll
        for (int ai = 0; ai < 2; ++ai)
#pragma unroll
            for (int m = 0; m < 4; ++m) { bf16_t* rowp = O + (size_t)(row0 + ai * HALF + m * 16) * ldc + col0;
#pragma unroll
                for (int bj = 0; bj < 2; ++bj) { const f32x4 v0 = act(acc[ai][bj][m][0], mode), v1 = act(acc[ai][bj][m][1], mode);
                    u32x4 w; w.x = cvt_pk_bf16(v0[0], v0[1]); w.y = cvt_pk_bf16(v0[2], v0[3]); w.z = cvt_pk_bf16(v1[0], v1[1]); w.w = cvt_pk_bf16(v1[2], v1[3]);
                    __builtin_nontemporal_store(w, (u32x4*)(rowp + bj * HALF)); } }
    }
};
struct EpiRes {
    static constexpr bool PERM = false;
    const float* base; float* out; const float* gate;
    __device__ __forceinline__ void operator()(const f32x4 (&acc)[2][2][4][2], const Unit& u, int wr, int wc, int fr, int fq) const {
        const int row0 = u.pm * BM + wr * 64 + fr, col0 = u.pn * BM + wc * 32 + 4 * fq;
        const float* gp = gate + (size_t)(u.pm >> 4) * 6144 + col0;
        f32x4 gv[2][2];
#pragma unroll
        for (int bj = 0; bj < 2; ++bj)
#pragma unroll
            for (int n = 0; n < 2; ++n) gv[bj][n] = *(const f32x4*)(gp + bj * HALF + n * 16);
#pragma unroll
        for (int ai = 0; ai < 2; ++ai)
#pragma unroll
            for (int m = 0; m < 4; ++m) { const size_t ro = (size_t)(row0 + ai * HALF + m * 16) * 1024 + col0;
#pragma unroll
                for (int bj = 0; bj < 2; ++bj)
#pragma unroll
                    for (int n = 0; n < 2; ++n) { f32x4 b = *(const f32x4*)(base + ro + bj * HALF + n * 16); __builtin_nontemporal_store(b + gv[bj][n] * acc[ai][bj][m][n], (f32x4*)(out + ro + bj * HALF + n * 16)); } }
    }
};

template <class Epi, bool ALIGN_EPI = true, bool SP2 = true>
__device__ __forceinline__ void gemm_phase(LAS unsigned char* lds, const Gemm g, const StaticOrder& S, const Epi& E) {
    const int tid = ltid(), wid = __builtin_amdgcn_readfirstlane(tid >> 6), lane = tid & 63, wr = wid >> 2, wc = wid & 3, fr = lane & 15, fq = lane >> 4;
    const int K = g.K, nt = K / BK;
    unsigned voffA[2], voffB[2];
#pragma unroll
    for (int i = 0; i < 2; ++i) { int R, C; stage_rc(tid * 16 + i * 8192, R, C); const int Rb = Epi::PERM ? ((R & ~31) + perm32(R & 31)) : R;
        voffA[i] = (unsigned)(R * K + C) * 2u; voffB[i] = (unsigned)(Rb * K + C) * 2u; }
    const size_t kstep = (size_t)(BK * 2);
    const size_t hstep = (size_t)HALF * K * 2;
    const size_t tstep = 2 * hstep;
    const unsigned ldsw = (unsigned)wid * 1024u;
    const int aoff = lds_byte(wr * 64 + fr, fq * 8), boff = lds_byte(wc * 32 + fr, fq * 8);
#define PG8_APTR(pm) ((pm) < g.pm_split ? (const char*)g.A + (size_t)(pm) * tstep : (const char*)g.A_hi + (size_t)((pm) - g.pm_split) * tstep)
#define PG8_SA(b, h) (((b) * 2 + (h)) * HTB)
#define PG8_SB(b, h) ((4 + (b) * 2 + (h)) * HTB)
#define PG8_STAGE(bufoff, gbase, voff) do { _Pragma("unroll") for (int _i = 0; _i < 2; ++_i) \
        __builtin_amdgcn_global_load_lds((const unsigned*)((const char*)(gbase) + (voff)[_i]), (LAS unsigned*)(lds + (bufoff) + ldsw + _i * 8192), 16, 0, 0); } while (0)
#define PG8_LDA(dst, b, h) do { _Pragma("unroll") for (int m = 0; m < 4; ++m) _Pragma("unroll") for (int k = 0; k < 2; ++k) dst[m][k] = *(const LAS bf16x8*)(lds + PG8_SA(b, h) + aoff + m * 2048 + k * 1024); } while (0)
#define PG8_LDB(dst, b, h) do { _Pragma("unroll") for (int n = 0; n < 2; ++n) _Pragma("unroll") for (int k = 0; k < 2; ++k) dst[n][k] = *(const LAS bf16x8*)(lds + PG8_SB(b, h) + boff + n * 2048 + k * 1024); } while (0)
#define PG8_MMA(ai, bj, At, Bt) do { __builtin_amdgcn_s_setprio(1); _Pragma("unroll") for (int m = 0; m < 4; ++m) _Pragma("unroll") for (int n = 0; n < 2; ++n) _Pragma("unroll") for (int k = 0; k < 2; ++k) \
        acc[ai][bj][m][n] = __builtin_amdgcn_mfma_f32_16x16x32_bf16(Bt[n][k], At[m][k], acc[ai][bj][m][n], 0, 0, 0); __builtin_amdgcn_s_setprio(0); } while (0)
#define PG8_WAIT_V(n) asm volatile("s_waitcnt vmcnt(" #n ")" ::: "memory")
#define PG8_WAIT_L(n) asm volatile("s_waitcnt lgkmcnt(" #n ")" ::: "memory")
#define PG8_BAR __builtin_amdgcn_s_barrier()
#define PG8_SCHED __builtin_amdgcn_sched_barrier(0)
    Unit cur, nxt; int ui = 0;
    if (!S.next(0, cur)) return;
    f32x4 acc[2][2][4][2];
#pragma unroll
    for (int a = 0; a < 2; ++a)
#pragma unroll
        for (int b = 0; b < 2; ++b)
#pragma unroll
            for (int m = 0; m < 4; ++m)
#pragma unroll
                for (int n = 0; n < 2; ++n) acc[a][b][m][n] = (f32x4){0.f, 0.f, 0.f, 0.f};
    bf16x8 At[4][2], B0[2][2], B1[2][2];
    const char* cA = PG8_APTR(cur.pm); const char* cB = (const char*)g.Bt + (size_t)cur.pn * tstep;
    if constexpr (SP2) {
        PG8_STAGE(PG8_SB(0, 0), cB, voffB); PG8_STAGE(PG8_SB(0, 1), cB + hstep, voffB); PG8_STAGE(PG8_SA(0, 0), cA, voffA); PG8_STAGE(PG8_SA(0, 1), cA + hstep, voffA);
        if (wr == 1) PG8_BAR;
        PG8_WAIT_V(2); PG8_BAR;
        PG8_STAGE(PG8_SB(1, 0), cB + kstep, voffB); PG8_STAGE(PG8_SA(1, 0), cA + kstep, voffA); PG8_STAGE(PG8_SB(1, 1), cB + hstep + kstep, voffB);
        PG8_WAIT_V(6); PG8_BAR;
    } else {
        PG8_STAGE(PG8_SB(0, 0), cB, voffB); PG8_STAGE(PG8_SA(0, 0), cA, voffA); PG8_STAGE(PG8_SB(0, 1), cB + hstep, voffB); PG8_STAGE(PG8_SA(0, 1), cA + hstep, voffA);
        if (wr == 1) PG8_BAR;
        PG8_WAIT_V(4); PG8_BAR;
        PG8_STAGE(PG8_SB(1, 0), cB + kstep, voffB); PG8_STAGE(PG8_SA(1, 0), cA + kstep, voffA); PG8_STAGE(PG8_SB(1, 1), cB + hstep + kstep, voffB);
        PG8_WAIT_V(6); PG8_BAR;
    }
    for (;;) {
        const bool has_next = S.next(ui + 1, nxt);
        const char* nA = has_next ? PG8_APTR(nxt.pm) : cA; const char* nB = has_next ? (const char*)g.Bt + (size_t)nxt.pn * tstep : cB;
        for (int t = 0; t < nt; t += 2) {
            const bool last = (t == nt - 2);
            const char* a1 = cA + (size_t)(t + 1) * kstep;
            const char* a2 = last ? nA : cA + (size_t)(t + 2) * kstep; const char* b2 = last ? nB : cB + (size_t)(t + 2) * kstep;
            const char* a3 = a2 + kstep; const char* b3 = b2 + kstep;
            if constexpr (SP2) {
            PG8_LDB(B0, 0, 0); PG8_LDB(B1, 0, 1); PG8_SCHED; PG8_LDA(At, 0, 0); PG8_STAGE(PG8_SA(1, 1), a1 + hstep, voffA);
            PG8_WAIT_V(8); PG8_WAIT_L(0); PG8_BAR; PG8_MMA(0, 0, At, B0); PG8_MMA(0, 1, At, B1); PG8_BAR; PG8_SCHED;
            PG8_LDA(At, 0, 1); PG8_STAGE(PG8_SB(0, 0), b2, voffB); PG8_STAGE(PG8_SB(0, 1), b2 + hstep, voffB); PG8_STAGE(PG8_SA(0, 0), a2, voffA);
            PG8_WAIT_V(8); PG8_WAIT_L(0); PG8_BAR; PG8_MMA(1, 0, At, B0); PG8_MMA(1, 1, At, B1); PG8_BAR; PG8_SCHED;
            PG8_LDB(B0, 1, 0); PG8_LDB(B1, 1, 1); PG8_SCHED; PG8_LDA(At, 1, 0); PG8_STAGE(PG8_SA(0, 1), a2 + hstep, voffA);
            PG8_WAIT_V(8); PG8_WAIT_L(0); PG8_BAR; PG8_MMA(0, 0, At, B0); PG8_MMA(0, 1, At, B1); PG8_BAR; PG8_SCHED;
            PG8_LDA(At, 1, 1); PG8_STAGE(PG8_SB(1, 0), b3, voffB); PG8_STAGE(PG8_SB(1, 1), b3 + hstep, voffB); PG8_STAGE(PG8_SA(1, 0), a3, voffA);
            PG8_WAIT_V(8); PG8_WAIT_L(0); PG8_BAR; PG8_MMA(1, 0, At, B0); PG8_MMA(1, 1, At, B1); PG8_BAR; PG8_SCHED;
            } else {
            PG8_LDB(B0, 0, 0); PG8_SCHED; PG8_LDA(At, 0, 0); PG8_STAGE(PG8_SA(1, 1), a1 + hstep, voffA);
            PG8_WAIT_L(8); PG8_BAR; PG8_WAIT_L(0); PG8_MMA(0, 0, At, B0); PG8_BAR; PG8_SCHED;
            PG8_LDB(B1, 0, 1); PG8_STAGE(PG8_SB(0, 0), b2, voffB);
            PG8_BAR; PG8_WAIT_L(0); PG8_MMA(0, 1, At, B1); PG8_BAR;
            PG8_LDA(At, 0, 1); PG8_STAGE(PG8_SA(0, 0), a2, voffA);
            PG8_BAR; PG8_WAIT_L(0); PG8_MMA(1, 0, At, B0); PG8_BAR; PG8_SCHED;
            PG8_STAGE(PG8_SB(0, 1), b2 + hstep, voffB);
            PG8_WAIT_V(6); PG8_BAR; PG8_MMA(1, 1, At, B1); PG8_BAR;
            PG8_LDB(B0, 1, 0); PG8_SCHED; PG8_LDA(At, 1, 0); PG8_STAGE(PG8_SA(0, 1), a2 + hstep, voffA);
            PG8_WAIT_L(8); PG8_BAR; PG8_WAIT_L(0); PG8_MMA(0, 0, At, B0); PG8_BAR; PG8_SCHED;
            PG8_LDB(B1, 1, 1); PG8_STAGE(PG8_SB(1, 0), b3, voffB);
            PG8_BAR; PG8_WAIT_L(0); PG8_MMA(0, 1, At, B1); PG8_BAR;
            PG8_LDA(At, 1, 1); PG8_STAGE(PG8_SA(1, 0), a3, voffA);
            PG8_BAR; PG8_WAIT_L(0); PG8_MMA(1, 0, At, B0); PG8_BAR; PG8_SCHED;
            PG8_STAGE(PG8_SB(1, 1), b3 + hstep, voffB);
            PG8_WAIT_V(6); PG8_BAR; PG8_MMA(1, 1, At, B1); PG8_BAR;
            }
        }
        if constexpr (ALIGN_EPI) { if (wr == 0) PG8_BAR; }
        E(acc, cur, wr, wc, fr, fq);
        if (!has_next) break;
#pragma unroll
        for (int a = 0; a < 2; ++a)
#pragma unroll
            for (int b = 0; b < 2; ++b)
#pragma unroll
                for (int m = 0; m < 4; ++m)
#pragma unroll
                    for (int n = 0; n < 2; ++n) acc[a][b][m][n] = (f32x4){0.f, 0.f, 0.f, 0.f};
        cur = nxt; cA = nA; cB = nB; ++ui;
        if constexpr (ALIGN_EPI) { if (wr == 1) PG8_BAR; }
    }
    PG8_WAIT_V(0);
    if constexpr (!ALIGN_EPI) { if (wr == 0) PG8_BAR; }
    PG8_BAR;
#undef PG8_APTR
#undef PG8_SA
#undef PG8_SB
#undef PG8_STAGE
#undef PG8_LDA
#undef PG8_LDB
#undef PG8_MMA
#undef PG8_WAIT_V
#undef PG8_WAIT_L
#undef PG8_BAR
#undef PG8_SCHED
}
}

__device__ void phase_p0(const Args& a, LAS unsigned char* lds) {
    const int tid = ltid();
    float* mod = (float*)(a.ws + WS_MOD);
    for (int it = lbid(); it < 192; it += gridDim.x) {
        LAS float* sS = (LAS float*)lds; LAS float* red = sS + 9 * 1024;
        for (int e = tid; e < 9 * 1024; e += NT) { const int i = e >> 10, k = e & 1023; const float v = (i < 8) ? a.c[i * 1024 + k] : a.c_ctx[k]; sS[e] = silu(v); }
        __syncthreads();
        const int col = tid & 31, ks = tid >> 5, j = it * 32 + col;
        float acc[9];
#pragma unroll
        for (int i = 0; i < 9; ++i) acc[i] = 0.f;
#pragma unroll 1
        for (int k8 = 0; k8 < 64; k8 += 16) { float w[16];
#pragma unroll
            for (int kk = 0; kk < 16; ++kk) w[kk] = a.w_mod[(size_t)(ks * 64 + k8 + kk) * 6144 + j];
#pragma unroll
            for (int kk = 0; kk < 16; ++kk) { const int k = ks * 64 + k8 + kk;
#pragma unroll
                for (int i = 0; i < 9; ++i) acc[i] += sS[i * 1024 + k] * w[kk]; } }
#pragma unroll
        for (int i = 0; i < 9; ++i) red[(ks * 9 + i) * 32 + col] = acc[i];
        __syncthreads();
        if (tid < 288) { const int i = tid >> 5, cc = tid & 31; float s = 0.f; for (int q = 0; q < 16; ++q) s += red[(q * 9 + i) * 32 + cc]; mod[i * 6144 + it * 32 + cc] = s + a.b_mod[it * 32 + cc]; }
        __syncthreads();
    }
    LAS float* tile = (LAS float*)lds;
    auto decode = [&](int tt, const float*& src, bf16_t*& dst, int& K, int& Ns, int& kt, int& ntl, int& scol) {
        if (tt < 1152) { src = a.w_in; dst = (bf16_t*)(a.ws + WS_WIN); K = 1024; Ns = 4624; kt = tt & 15; ntl = tt >> 4; scol = ntl * 64; if (scol >= 2048) scol += 16; }
        else if (tt < 1408) { const int u = tt - 1152; src = a.w_out; dst = (bf16_t*)(a.ws + WS_WOUT); K = 1024; Ns = 1024; kt = u & 15; ntl = u >> 4; scol = ntl * 64; }
        else if (tt < 2816) { const int u = tt - 1408; src = a.w_up; dst = (bf16_t*)(a.ws + WS_WUP); K = 1024; Ns = 5632; kt = u & 15; ntl = u >> 4; scol = ntl * 64; }
        else { const int u = tt - 2816; src = a.w_down; dst = (bf16_t*)(a.ws + WS_WDN); K = 2816; Ns = 1024; kt = u % 44; ntl = u / 44; scol = ntl * 64; } };
    const int tkk = tid >> 4, tn4 = (tid & 15) * 4;
    auto ldtile = [&](int tt, f32x4& v0, f32x4& v1) { const float* src; bf16_t* dst; int K, Ns, kt, ntl, scol; decode(tt, src, dst, K, Ns, kt, ntl, scol);
        v0 = *(const f32x4*)(src + (size_t)(kt * 64 + tkk) * Ns + scol + tn4); v1 = *(const f32x4*)(src + (size_t)(kt * 64 + tkk + 32) * Ns + scol + tn4); };
    f32x4 c0, c1, n0, n1; int tt = lbid();
    if (tt < 3520) ldtile(tt, c0, c1);
    for (; tt < 3520; tt += gridDim.x) {
        const int tnx = tt + gridDim.x; if (tnx < 3520) ldtile(tnx, n0, n1);
        const float* src; bf16_t* dst; int K, Ns, kt, ntl, scol; decode(tt, src, dst, K, Ns, kt, ntl, scol);
        tile[tkk * 65 + tn4] = c0[0]; tile[tkk * 65 + tn4 + 1] = c0[1]; tile[tkk * 65 + tn4 + 2] = c0[2]; tile[tkk * 65 + tn4 + 3] = c0[3];
        tile[(tkk + 32) * 65 + tn4] = c1[0]; tile[(tkk + 32) * 65 + tn4 + 1] = c1[1]; tile[(tkk + 32) * 65 + tn4 + 2] = c1[2]; tile[(tkk + 32) * 65 + tn4 + 3] = c1[3];
        __syncthreads();
        { const int n = tid >> 3, k8 = (tid & 7) * 8; u32x4 w;
          w.x = pack2(tile[(k8 + 0) * 65 + n], tile[(k8 + 1) * 65 + n]); w.y = pack2(tile[(k8 + 2) * 65 + n], tile[(k8 + 3) * 65 + n]);
          w.z = pack2(tile[(k8 + 4) * 65 + n], tile[(k8 + 5) * 65 + n]); w.w = pack2(tile[(k8 + 6) * 65 + n], tile[(k8 + 7) * 65 + n]);
          *(u32x4*)(dst + (size_t)(ntl * 64 + n) * K + kt * 64 + k8) = w; }
        __syncthreads();
        c0 = n0; c1 = n1;
    }
}

__device__ void phase_p1(const Args& a, LAS unsigned char* lds) {
    const int tid = ltid(), lane = tid & 63, wave = tid >> 6;
    LAS float* wgT = (LAS float*)lds;
    for (int e = tid; e < 16384; e += NT) { const int k = e >> 4, j = e & 15; wgT[j * 1024 + k] = a.w_in[(size_t)k * 4624 + 2048 + j]; }
    __syncthreads();
    const float* mod = (const float*)(a.ws + WS_MOD);
    bf16_t* A1 = (bf16_t*)(a.ws + WS_R1);
    float* gates = (float*)(a.ws + WS_GATES);
    const int rstep = gridDim.x * 8;
    for (int row0 = lbid() * 8 + wave; row0 < NROWS; row0 += 2 * rstep) {
        const int row1r = row0 + rstep; const bool has1 = row1r < NROWS; const int row1 = has1 ? row1r : row0;
        const float* src0 = row0 < NLAT ? a.x + (size_t)row0 * 1024 : a.ctx + (size_t)(row0 - NLAT) * 1024;
        const float* src1 = row1 < NLAT ? a.x + (size_t)row1 * 1024 : a.ctx + (size_t)(row1 - NLAT) * 1024;
        const float* mb0 = mod + (row0 < NLAT ? (row0 >> 12) : 8) * 6144; const float* mb1 = mod + (row1 < NLAT ? (row1 >> 12) : 8) * 6144;
        float ss0 = 0.f, ss1 = 0.f;
#pragma unroll
        for (int i = 0; i < 8; ++i) { const f32x2 x0 = *(const f32x2*)(src0 + i * 128 + lane * 2), x1 = *(const f32x2*)(src1 + i * 128 + lane * 2); ss0 += x0.x * x0.x + x0.y * x0.y; ss1 += x1.x * x1.x + x1.y * x1.y; }
        ss0 = wsum(ss0); ss1 = wsum(ss1);
        const float rs0 = rsqrtf(ss0 * (1.f / 1024.f) + 1e-6f), rs1 = rsqrtf(ss1 * (1.f / 1024.f) + 1e-6f);
        float g0[16], g1[16];
#pragma unroll
        for (int j = 0; j < 16; ++j) { g0[j] = 0.f; g1[j] = 0.f; }
        f32x2 xv0 = *(const f32x2*)(src0 + lane * 2), xv1 = *(const f32x2*)(src1 + lane * 2), nw = *(const f32x2*)(a.norm1_w + lane * 2);
        f32x2 sh0 = *(const f32x2*)(mb0 + lane * 2), sc0 = *(const f32x2*)(mb0 + 1024 + lane * 2), sh1 = *(const f32x2*)(mb1 + lane * 2), sc1 = *(const f32x2*)(mb1 + 1024 + lane * 2);
#pragma unroll 1
        for (int i = 0; i < 8; ++i) { const int k = i * 128 + lane * 2; const int kn = ((i + 1) & 7) * 128 + lane * 2;
            const f32x2 xn0 = *(const f32x2*)(src0 + kn), xn1 = *(const f32x2*)(src1 + kn), nwn = *(const f32x2*)(a.norm1_w + kn);
            const f32x2 shn0 = *(const f32x2*)(mb0 + kn), scn0 = *(const f32x2*)(mb0 + 1024 + kn), shn1 = *(const f32x2*)(mb1 + kn), scn1 = *(const f32x2*)(mb1 + 1024 + kn);
            const float a00 = xv0.x * rs0 * nw.x * (1.f + sc0.x) + sh0.x, a01 = xv0.y * rs0 * nw.y * (1.f + sc0.y) + sh0.y;
            const float a10 = xv1.x * rs1 * nw.x * (1.f + sc1.x) + sh1.x, a11 = xv1.y * rs1 * nw.y * (1.f + sc1.y) + sh1.y;
            *(unsigned*)(A1 + (size_t)row0 * 1024 + k) = pack2(a00, a01);
            if (has1) *(unsigned*)(A1 + (size_t)row1 * 1024 + k) = pack2(a10, a11);
#pragma unroll
            for (int j = 0; j < 16; ++j) { const f32x2 w = *(const LAS f32x2*)(wgT + j * 1024 + k); g0[j] += a00 * w.x + a01 * w.y; g1[j] += a10 * w.x + a11 * w.y; }
            xv0 = xn0; xv1 = xn1; nw = nwn; sh0 = shn0; sc0 = scn0; sh1 = shn1; sc1 = scn1; }
        float out0 = 0.f, out1 = 0.f;
#pragma unroll
        for (int j = 0; j < 16; ++j) { const float s0 = wsum(g0[j]), s1 = wsum(g1[j]); if (lane == j) { out0 = s0; out1 = s1; } }
        if (lane < 16) { gates[(size_t)row0 * 16 + lane] = out0 + a.gate_b[lane]; if (has1) gates[(size_t)row1 * 16 + lane] = out1 + a.gate_b[lane]; }
    }
}

__device__ void phase_n2(const Args& a) {
    const int tid = ltid(), lane = tid & 63, wave = tid >> 6;
    const float* mod = (const float*)(a.ws + WS_MOD);
    bf16_t* A2 = (bf16_t*)(a.ws + WS_A2);
    const int rstep = gridDim.x * 8;
    for (int row0 = lbid() * 8 + wave; row0 < NLAT; row0 += 2 * rstep) {
        f32x4 v[2][4]; float ss[2] = {0.f, 0.f};
#pragma unroll
        for (int q = 0; q < 2; ++q) { const int row = row0 + q * rstep; if (row < NLAT) { const float* src = a.out + (size_t)row * 1024;
#pragma unroll
            for (int i = 0; i < 4; ++i) v[q][i] = *(const f32x4*)(src + i * 256 + lane * 4); } }
#pragma unroll
        for (int q = 0; q < 2; ++q) { const int row = row0 + q * rstep; if (row < NLAT) {
#pragma unroll
            for (int i = 0; i < 4; ++i) ss[q] += v[q][i][0] * v[q][i][0] + v[q][i][1] * v[q][i][1] + v[q][i][2] * v[q][i][2] + v[q][i][3] * v[q][i][3]; } }
        ss[0] = wsum(ss[0]); ss[1] = wsum(ss[1]);
#pragma unroll
        for (int q = 0; q < 2; ++q) { const int row = row0 + q * rstep; if (row < NLAT) { const float rs = rsqrtf(ss[q] * (1.f / 1024.f) + 1e-6f); const float* mb = mod + (row >> 12) * 6144;
#pragma unroll
            for (int i = 0; i < 4; ++i) { const int k = i * 256 + lane * 4;
                const f32x4 nw = *(const f32x4*)(a.norm2_w + k), sh = *(const f32x4*)(mb + 3072 + k), sc = *(const f32x4*)(mb + 4096 + k);
                u32x2 w; w.x = pack2(v[q][i][0] * rs * nw[0] * (1.f + sc[0]) + sh[0], v[q][i][1] * rs * nw[1] * (1.f + sc[1]) + sh[1]);
                w.y = pack2(v[q][i][2] * rs * nw[2] * (1.f + sc[2]) + sh[2], v[q][i][3] * rs * nw[3] * (1.f + sc[3]) + sh[3]);
                *(u32x2*)(A2 + (size_t)row * 1024 + k) = w; } } }
    }
}
__device__ void phase_fn(const Args& a) {
    const int tid = ltid(), lane = tid & 63, wave = tid >> 6;
    const int rstep = gridDim.x * 8;
    f32x4 nw[4];
#pragma unroll
    for (int i = 0; i < 4; ++i) nw[i] = *(const f32x4*)(a.final_w + i * 256 + lane * 4);
    for (int row0 = lbid() * 8 + wave; row0 < NLAT; row0 += 2 * rstep) {
        f32x4 v[2][4]; float ss[2] = {0.f, 0.f};
#pragma unroll
        for (int q = 0; q < 2; ++q) { const int row = row0 + q * rstep; if (row < NLAT) { const float* src = a.out + (size_t)row * 1024;
#pragma unroll
            for (int i = 0; i < 4; ++i) v[q][i] = *(const f32x4*)(src + i * 256 + lane * 4); } }
#pragma unroll
        for (int q = 0; q < 2; ++q) { const int row = row0 + q * rstep; if (row < NLAT) {
#pragma unroll
            for (int i = 0; i < 4; ++i) ss[q] += v[q][i][0] * v[q][i][0] + v[q][i][1] * v[q][i][1] + v[q][i][2] * v[q][i][2] + v[q][i][3] * v[q][i][3]; } }
        ss[0] = wsum(ss[0]); ss[1] = wsum(ss[1]);
#pragma unroll
        for (int q = 0; q < 2; ++q) { const int row = row0 + q * rstep; if (row < NLAT) { const float rs = rsqrtf(ss[q] * (1.f / 1024.f) + 1e-6f); float* dst = a.out + (size_t)row * 1024;
#pragma unroll
            for (int i = 0; i < 4; ++i) *(f32x4*)(dst + i * 256 + lane * 4) = v[q][i] * rs * nw[i]; } }
    }
}

__device__ void phase_mc(const Args& a) {
    const int tid = ltid(), cgi = tid & 127, seg = tid >> 7, c0 = cgi * 8;
    const bf16_t* P = (const bf16_t*)(a.ws + WS_P); bf16_t* QK = (bf16_t*)(a.ws + WS_R1);
    float w[9][8];
#pragma unroll
    for (int t = 0; t < 9; ++t) { const f32x4 w0 = *(const f32x4*)(a.ml_conv_w + t * 1024 + c0), w1 = *(const f32x4*)(a.ml_conv_w + t * 1024 + c0 + 4);
        w[t][0] = w0[0]; w[t][1] = w0[1]; w[t][2] = w0[2]; w[t][3] = w0[3]; w[t][4] = w1[0]; w[t][5] = w1[1]; w[t][6] = w1[2]; w[t][7] = w1[3]; }
    const float qs = (c0 < 512) ? 0.08838834764831845f : 1.f;
    for (int it = lbid(); it < 640; it += gridDim.x) {
        int rowbase, W, H, y0, nrows, xb;
        if (it < 512) { const int b = it >> 6; rowbase = b * 4096; W = 64; H = 64; y0 = ((it >> 2) & 15) * 4; nrows = 4; xb = (it & 3) * 16; }
        else { const int ci = it - 512; rowbase = NLAT + (ci >> 4) * 256; W = 256; H = 1; y0 = 0; nrows = 1; xb = (ci & 15) * 16; }
        const int x0 = xb + seg * 4;
        u32x4 r[3][6];
        auto ldrow = [&](int y, u32x4 (&d)[6]) {
            const bool vy = (y >= 0 && y < H);
#pragma unroll
            for (int j = 0; j < 6; ++j) { const int xx = x0 - 1 + j;
                d[j] = (vy && xx >= 0 && xx < W) ? *(const u32x4*)(P + (size_t)(rowbase + y * W + xx) * NPC + c0) : (u32x4){0u, 0u, 0u, 0u}; } };
        ldrow(y0 - 1, r[0]); ldrow(y0, r[1]);
#pragma unroll 1
        for (int ry = 0; ry < nrows; ++ry) { const int y = y0 + ry;
            ldrow(y + 1, r[2]);
#pragma unroll
            for (int xi = 0; xi < 4; ++xi) {
                float acc[8];
#pragma unroll
                for (int e = 0; e < 8; ++e) acc[e] = 0.f;
#pragma unroll
                for (int dy = 0; dy < 3; ++dy)
#pragma unroll
                    for (int dx = 0; dx < 3; ++dx) { const u32x4 d = r[dy][xi + dx]; const int t = dy * 3 + dx;
                        acc[0] += lo_f(d.x) * w[t][0]; acc[1] += hi_f(d.x) * w[t][1]; acc[2] += lo_f(d.y) * w[t][2]; acc[3] += hi_f(d.y) * w[t][3];
                        acc[4] += lo_f(d.z) * w[t][4]; acc[5] += hi_f(d.z) * w[t][5]; acc[6] += lo_f(d.w) * w[t][6]; acc[7] += hi_f(d.w) * w[t][7]; }
                u32x4 o; o.x = pack2(silu(acc[0]) * qs, silu(acc[1]) * qs); o.y = pack2(silu(acc[2]) * qs, silu(acc[3]) * qs);
                o.z = pack2(silu(acc[4]) * qs, silu(acc[5]) * qs); o.w = pack2(silu(acc[6]) * qs, silu(acc[7]) * qs);
                *(u32x4*)(QK + (size_t)(rowbase + y * W + x0 + xi) * 1024 + c0) = o; }
#pragma unroll
            for (int j = 0; j < 6; ++j) { r[0][j] = r[1][j]; r[1][j] = r[2][j]; }
        }
    }
}

__device__ void phase_cv(const Args& a, int b_lo, bf16_t* ACT) {
    const int tid = ltid(), cgl = tid & 31, seg = tid >> 5;
    const bf16_t* U = (const bf16_t*)(a.ws + WS_U);
    for (int it = lbid(); it < 1408; it += gridDim.x) {
        const int cb = it % 22, band = (it / 22) & 15, bb = it / 352;
        const int c = cb * 128 + cgl * 4, y0 = band * 4, x0 = seg * 4;
        float wa[9][4], wb[9][4];
#pragma unroll
        for (int t = 0; t < 9; ++t) { const f32x4 w0 = *(const f32x4*)(a.ffn_conv_w + t * 5632 + c), w1 = *(const f32x4*)(a.ffn_conv_w + t * 5632 + 2816 + c);
            wa[t][0] = w0[0]; wa[t][1] = w0[1]; wa[t][2] = w0[2]; wa[t][3] = w0[3]; wb[t][0] = w1[0]; wb[t][1] = w1[1]; wb[t][2] = w1[2]; wb[t][3] = w1[3]; }
        const size_t rowb = (size_t)(b_lo + bb) * 4096;
        u32x2 ra[3][6], rbv[3][6];
        auto ldrow = [&](int y, u32x2 (&da)[6], u32x2 (&db)[6]) {
            const bool vy = (y >= 0 && y < 64);
#pragma unroll
            for (int j = 0; j < 6; ++j) { const int xx = x0 - 1 + j;
                if (vy && xx >= 0 && xx < 64) { const bf16_t* p = U + (rowb + y * 64 + xx) * 5632 + c; da[j] = *(const u32x2*)p; db[j] = *(const u32x2*)(p + 2816); }
                else { da[j] = (u32x2){0u, 0u}; db[j] = (u32x2){0u, 0u}; } } };
        ldrow(y0 - 1, ra[0], rbv[0]); ldrow(y0, ra[1], rbv[1]);
#pragma unroll
        for (int ry = 0; ry < 4; ++ry) { const int y = y0 + ry;
            ldrow(y + 1, ra[2], rbv[2]);
#pragma unroll
            for (int xi = 0; xi < 4; ++xi) {
                float aa[4] = {0.f, 0.f, 0.f, 0.f}, ab[4] = {0.f, 0.f, 0.f, 0.f};
#pragma unroll
                for (int dy = 0; dy < 3; ++dy)
#pragma unroll
                    for (int dx = 0; dx < 3; ++dx) { const int t = dy * 3 + dx; const u32x2 d = ra[dy][xi + dx], e = rbv[dy][xi + dx];
                        aa[0] += lo_f(d.x) * wa[t][0]; aa[1] += hi_f(d.x) * wa[t][1]; aa[2] += lo_f(d.y) * wa[t][2]; aa[3] += hi_f(d.y) * wa[t][3];
                        ab[0] += lo_f(e.x) * wb[t][0]; ab[1] += hi_f(e.x) * wb[t][1]; ab[2] += lo_f(e.y) * wb[t][2]; ab[3] += hi_f(e.y) * wb[t][3]; }
                u32x2 o; o.x = pack2(silu(aa[0]) * ab[0], silu(aa[1]) * ab[1]); o.y = pack2(silu(aa[2]) * ab[2], silu(aa[3]) * ab[3]);
                *(u32x2*)(ACT + ((size_t)bb * 4096 + y * 64 + x0 + xi) * 2816 + c) = o; }
#pragma unroll
            for (int j = 0; j < 6; ++j) { ra[0][j] = ra[1][j]; ra[1][j] = ra[2][j]; rbv[0][j] = rbv[1][j]; rbv[1][j] = rbv[2][j]; }
        }
    }
}

__device__ __forceinline__ void ml_scan(const LAS float* lf, const LAS float* ig, bool rev, int lane, float (&b)[4], float (&c)[4], float (&gm)[4], float& Btot, float& cmax) {
    float l[4], s = 0.f;
#pragma unroll
    for (int i = 0; i < 4; ++i) { const int p = 4 * lane + i, t = rev ? 255 - p : p; l[i] = lf[t]; s += l[i]; }
    const float incl = wscan_add(s, lane); float run = incl - s; Btot = __shfl(incl, 63);
    float cm = -INFINITY;
#pragma unroll
    for (int i = 0; i < 4; ++i) { const int p = 4 * lane + i, t = rev ? 255 - p : p; run += l[i]; b[i] = run; c[i] = ig[t] - run; cm = fmaxf(cm, c[i]); gm[i] = cm; }
    const float im = wscan_max(cm, lane); float ex = __shfl_up(im, 1); if (lane == 0) ex = -INFINITY;
#pragma unroll
    for (int i = 0; i < 4; ++i) gm[i] = fmaxf(gm[i], ex);
    cmax = __shfl(im, 63);
}

__device__ __forceinline__ void m1_matmul_store(const LAS unsigned char* vT, const LAS unsigned char* kT, bf16_t* dst, int wave, int lane) {
    const int r = lane & 15, kg = lane >> 4;
    f32x4 acc[8];
#pragma unroll
    for (int n = 0; n < 8; ++n) acc[n] = (f32x4){0.f, 0.f, 0.f, 0.f};
    const LAS unsigned char* pa = vT + (wave * 16 + r) * 528 + kg * 16;
    const LAS unsigned char* pb = kT + r * 528 + kg * 16;
#pragma unroll 2
    for (int ks = 0; ks < 8; ++ks) { const bf16x8 av = *(const LAS bf16x8*)(pa + ks * 64);
#pragma unroll
        for (int n = 0; n < 8; ++n) { const bf16x8 bv = *(const LAS bf16x8*)(pb + n * 16 * 528 + ks * 64); acc[n] = MFMA16(av, bv, acc[n]); } }
#pragma unroll
    for (int n = 0; n < 8; ++n)
#pragma unroll
        for (int j = 0; j < 4; ++j) dst[(wave * 16 + kg * 4 + j) * 128 + n * 16 + r] = f2bf(acc[n][j]);
}

__device__ __forceinline__ void load_vT256(const bf16_t* src, int ld, LAS unsigned char* vT, int tid) {
    const int s = tid & 255, half = tid >> 8;
    const bf16_t* p = src + (size_t)s * ld + half * 64;
#pragma unroll
    for (int q = 0; q < 8; ++q) { const u32x4 d = *(const u32x4*)(p + q * 8); const int cb = half * 64 + q * 8;
        LAS bf16_t* o = (LAS bf16_t*)vT + cb * 264 + s;
        o[0] = (bf16_t)(d.x & 0xffff); o[264] = (bf16_t)(d.x >> 16); o[2 * 264] = (bf16_t)(d.y & 0xffff); o[3 * 264] = (bf16_t)(d.y >> 16);
        o[4 * 264] = (bf16_t)(d.z & 0xffff); o[5 * 264] = (bf16_t)(d.z >> 16); o[6 * 264] = (bf16_t)(d.w & 0xffff); o[7 * 264] = (bf16_t)(d.w >> 16); }
}

constexpr int M1_VT = 0, M1_KT = 67584, M1_MISC = 135168;
__device__ void m1_hg_item(const Args& a, LAS unsigned char* lds, int rowbase, int h, int seqF, int slotF, int slotB);

__device__ void phase_m1(const Args& a, LAS unsigned char* lds) {
    const int tid = ltid(), lane = tid & 63, wave = tid >> 6;
    const bf16_t* P = (const bf16_t*)(a.ws + WS_P); const bf16_t* QK = (const bf16_t*)(a.ws + WS_R1);
    const float* gates = (const float*)(a.ws + WS_GATES);
    bf16_t* mlst = (bf16_t*)a.out; bf16_t* hgst = (bf16_t*)a.out + (size_t)1024 * 16384;
    float* ml_n = (float*)(a.ws + WS_SMALL + SM_MLN); float* hg_B = (float*)(a.ws + WS_SMALL + SM_HGB);
    float* ml_mloc = (float*)(a.ws + WS_SMALL + SM_MLOC); float* ml_B = (float*)(a.ws + WS_SMALL + SM_MLB);
    LAS unsigned char* vT = lds + M1_VT; LAS unsigned char* kT = lds + M1_KT;
    LAS float* misc = (LAS float*)(lds + M1_MISC);
    LAS float *lfF = misc, *igF = misc + 256, *lfB = misc + 512, *igB = misc + 768, *wF = misc + 1024, *wB = misc + 1280, *scal = misc + 1536, *nred = misc + 1552;
    const int nblk = gridDim.x, bidx = lbid(); const int nheavy3 = (nblk == 256) ? 64 : 0;
    for (int pass = 0; pass < 2; ++pass) {
      const bool isml = pass == 1; const int qstart = isml ? bidx - nheavy3 : bidx, qstride = isml ? nblk - nheavy3 : nblk, qend = isml ? 544 : 1088;
      if (qstart < 0) continue;
      for (int qq = qstart; qq < qend; qq += qstride) {
        const int q = isml ? qq : (qq >> 1); const int hdir = qq & 1;
        const int b = q / 68, h = (q / 17) & 3, sc = q % 17;
        const int rowbase = sc == 0 ? NLAT + b * 256 : b * 4096 + (sc - 1) * 256;
        int slotF = sc <= 15 ? sc : -1, slotB = sc == 0 ? 0 : (sc >= 2 ? 17 - sc : -1);
        if (!isml) { if (hdir) slotF = -1; else slotB = -1; if (slotF < 0 && slotB < 0) continue; }
        const int seqF = (b * 4 + h) * 2, seqB = seqF + 1;
        __syncthreads();
        if (isml) {
            if (tid < 256) { const float* g = gates + (size_t)(rowbase + tid) * 16; igF[tid] = g[h]; lfF[tid] = logsig(g[4 + h]); igB[tid] = g[8 + h]; lfB[tid] = logsig(g[12 + h]); }
            load_vT256(P + (size_t)rowbase * NPC + 1024 + h * 128, NPC, vT, tid);
            __syncthreads();
            if (wave < 2) { float bb[4], cc[4], gm[4], Bt, cmx; const bool rev = wave == 1;
                ml_scan(rev ? lfB : lfF, rev ? igB : igF, rev, lane, bb, cc, gm, Bt, cmx);
                LAS float* wd = rev ? wB : wF;
#pragma unroll
                for (int i = 0; i < 4; ++i) { const int p = 4 * lane + i, t = rev ? 255 - p : p; wd[t] = __expf(cc[i] - cmx); }
                if (lane == 0) { scal[wave * 2] = Bt + cmx; scal[wave * 2 + 1] = Bt; } }
            const int s = tid & 255, half = tid >> 8;
            u32x4 kr[8];
            { const bf16_t* p = QK + (size_t)(rowbase + s) * 1024 + 512 + h * 128 + half * 64;
#pragma unroll
              for (int qq = 0; qq < 8; ++qq) kr[qq] = *(const u32x4*)(p + qq * 8); }
            __syncthreads();
#pragma unroll
            for (int dir = 0; dir < 2; ++dir) {
                const int slot = dir ? slotB : slotF; const int seq = dir ? seqB : seqF;
                if (slot >= 0) {
                    const float wv = dir ? wB[s] : wF[s];
#pragma unroll
                    for (int qq = 0; qq < 8; ++qq) { const u32x4 d = kr[qq]; LAS bf16_t* o = (LAS bf16_t*)kT + (half * 64 + qq * 8) * 264 + s;
                        o[0] = f2bf(lo_f(d.x) * wv); o[264] = f2bf(hi_f(d.x) * wv); o[2 * 264] = f2bf(lo_f(d.y) * wv); o[3 * 264] = f2bf(hi_f(d.y) * wv);
                        o[4 * 264] = f2bf(lo_f(d.z) * wv); o[5 * 264] = f2bf(hi_f(d.z) * wv); o[6 * 264] = f2bf(lo_f(d.w) * wv); o[7 * 264] = f2bf(hi_f(d.w) * wv); }
                    __syncthreads();
                    m1_matmul_store(vT, kT, mlst + (size_t)(seq * 16 + slot) * 16384, wave, lane);
                    { const int dk = tid & 127, part = tid >> 7; float sm = 0.f; const LAS bf16_t* kp = (const LAS bf16_t*)kT + dk * 264 + part * 64;
                      for (int e = 0; e < 64; ++e) sm += bf2f(kp[e]);
                      nred[part * 128 + dk] = sm; }
                    __syncthreads();
                    if (tid < 128) ml_n[(size_t)(seq * 16 + slot) * 128 + tid] = nred[tid] + nred[128 + tid] + nred[256 + tid] + nred[384 + tid];
                    if (tid == 0) { ml_mloc[seq * 16 + slot] = scal[dir * 2]; ml_B[seq * 16 + slot] = scal[dir * 2 + 1]; }
                }
            }
        } else {
            m1_hg_item(a, lds, rowbase, h, seqF, slotF, slotB);
        }
    }
  }
}

__device__ void phase_m2(const Args& a) {
    bf16_t* mlst = (bf16_t*)a.out; bf16_t* hgst = (bf16_t*)a.out + (size_t)1024 * 16384;
    float* ml_n = (float*)(a.ws + WS_SMALL + SM_MLN); const float* hg_B = (const float*)(a.ws + WS_SMALL + SM_HGB);
    const float* ml_mloc = (const float*)(a.ws + WS_SMALL + SM_MLOC); const float* ml_B = (const float*)(a.ws + WS_SMALL + SM_MLB); float* ml_mpre = (float*)(a.ws + WS_SMALL + SM_MPRE);
    const int gtid = lbid() * NT + ltid(), gn = gridDim.x * NT;
    for (int g = gtid; g < 64 * 2048; g += gn) {
        const int seq = g >> 11, ch = g & 2047;
        bf16_t* base = mlst + (size_t)seq * 16 * 16384 + ch * 8;
        float m = ml_mloc[seq * 16]; float C[8];
        { const u32x4 d = *(const u32x4*)base; C[0] = lo_f(d.x); C[1] = hi_f(d.x); C[2] = lo_f(d.y); C[3] = hi_f(d.y); C[4] = lo_f(d.z); C[5] = hi_f(d.z); C[6] = lo_f(d.w); C[7] = hi_f(d.w); }
        if (ch == 0) ml_mpre[seq * 16] = m;
        u32x4 dnx = *(const u32x4*)(base + (size_t)16384);
        for (int p = 1; p < 16; ++p) { const float ml = ml_mloc[seq * 16 + p], B = ml_B[seq * 16 + p]; const float mn = fmaxf(B + m, ml); const float fa = __expf(B + m - mn), fb = __expf(ml - mn);
            const u32x4 d = dnx; if (p < 15) dnx = *(const u32x4*)(base + (size_t)(p + 1) * 16384);
            C[0] = fa * C[0] + fb * lo_f(d.x); C[1] = fa * C[1] + fb * hi_f(d.x); C[2] = fa * C[2] + fb * lo_f(d.y); C[3] = fa * C[3] + fb * hi_f(d.y);
            C[4] = fa * C[4] + fb * lo_f(d.z); C[5] = fa * C[5] + fb * hi_f(d.z); C[6] = fa * C[6] + fb * lo_f(d.w); C[7] = fa * C[7] + fb * hi_f(d.w);
            u32x4 o; o.x = pack2(C[0], C[1]); o.y = pack2(C[2], C[3]); o.z = pack2(C[4], C[5]); o.w = pack2(C[6], C[7]);
            *(u32x4*)(base + (size_t)p * 16384) = o; m = mn; if (ch == 0) ml_mpre[seq * 16 + p] = m; }
    }
    for (int g = gtid; g < 64 * 128; g += gn) {
        const int seq = g >> 7, dk = g & 127; float* base = ml_n + (size_t)seq * 16 * 128 + dk;
        float m = ml_mloc[seq * 16], n = base[0];
        for (int p = 1; p < 16; ++p) { const float ml = ml_mloc[seq * 16 + p], B = ml_B[seq * 16 + p]; const float mn = fmaxf(B + m, ml);
            n = __expf(B + m - mn) * n + __expf(ml - mn) * base[p * 128]; base[p * 128] = n; m = mn; }
    }
    for (int g = gtid; g < 64 * 2048; g += gn) {
        const int seq = g >> 11, ch = g & 2047, dk0 = (ch * 8) & 127;
        bf16_t* base = hgst + (size_t)seq * 16 * 16384 + ch * 8;
        float C[8];
        { const u32x4 d = *(const u32x4*)base; C[0] = lo_f(d.x); C[1] = hi_f(d.x); C[2] = lo_f(d.y); C[3] = hi_f(d.y); C[4] = lo_f(d.z); C[5] = hi_f(d.z); C[6] = lo_f(d.w); C[7] = hi_f(d.w); }
        u32x4 dnx = *(const u32x4*)(base + (size_t)16384);
        for (int p = 1; p < 16; ++p) { const float* bp = hg_B + (size_t)(seq * 16 + p) * 128 + dk0; const f32x4 b0 = *(const f32x4*)bp, b1 = *(const f32x4*)(bp + 4);
            const u32x4 d = dnx; if (p < 15) dnx = *(const u32x4*)(base + (size_t)(p + 1) * 16384);
            C[0] = __expf(b0[0]) * C[0] + lo_f(d.x); C[1] = __expf(b0[1]) * C[1] + hi_f(d.x); C[2] = __expf(b0[2]) * C[2] + lo_f(d.y); C[3] = __expf(b0[3]) * C[3] + hi_f(d.y);
            C[4] = __expf(b1[0]) * C[4] + lo_f(d.z); C[5] = __expf(b1[1]) * C[5] + hi_f(d.z); C[6] = __expf(b1[2]) * C[6] + lo_f(d.w); C[7] = __expf(b1[3]) * C[7] + hi_f(d.w);
            u32x4 o; o.x = pack2(C[0], C[1]); o.y = pack2(C[2], C[3]); o.z = pack2(C[4], C[5]); o.w = pack2(C[6], C[7]);
            *(u32x4*)(base + (size_t)p * 16384) = o; }
    }
}

constexpr int HG_Q1 = 0, HG_K1 = 17408, HG_KST = 34816, HG_VT = 53248, HG_PB = 71680, HG_ST = 80896, HG_MISC = 115712;

struct StageRegs { u32x4 a0, a1, b0, b1, v0, v1; float g0, g1; };
template <int DIR, bool OUT>
__device__ __forceinline__ void hg_fetch(const Args& a, int rb, int h, StageRegs& R) {
    const int tid = ltid(); const bf16_t* P = (const bf16_t*)(a.ws + WS_P);
    const int s = tid >> 3, sg8 = tid & 7; const bf16_t* rp = P + (size_t)(rb + s) * NPC + h * 128 + sg8 * 16;
    R.a0 = *(const u32x4*)(rp + 2560 + DIR * 512); R.a1 = *(const u32x4*)(rp + 2560 + DIR * 512 + 8);
    if (OUT) { R.b0 = *(const u32x4*)(rp + 2048); R.b1 = *(const u32x4*)(rp + 2048 + 8); }
    const int s2 = tid & 63, cp = tid >> 6; const bf16_t* vp = P + (size_t)(rb + s2) * NPC + 3584 + h * 128 + cp * 16;
    R.v0 = *(const u32x4*)vp; R.v1 = *(const u32x4*)(vp + 8);
}
__device__ __forceinline__ void stage_vT64(LAS unsigned char* lds, int tid, const u32x4& d0, const u32x4& d1) {
    const int s2 = tid & 63, cp = tid >> 6;
#pragma unroll
    for (int qq = 0; qq < 2; ++qq) { const u32x4 d = qq ? d1 : d0; LAS bf16_t* o = (LAS bf16_t*)(lds + HG_VT) + (cp * 16 + qq * 8) * 72 + s2;
        o[0] = (bf16_t)(d.x & 0xffff); o[72] = (bf16_t)(d.x >> 16); o[2 * 72] = (bf16_t)(d.y & 0xffff); o[3 * 72] = (bf16_t)(d.y >> 16);
        o[4 * 72] = (bf16_t)(d.z & 0xffff); o[5 * 72] = (bf16_t)(d.z >> 16); o[6 * 72] = (bf16_t)(d.w & 0xffff); o[7 * 72] = (bf16_t)(d.w >> 16); }
}
template <int DIR, bool OUT>
__device__ __forceinline__ void hg_sub(const Args& a, LAS unsigned char* lds, int rbn, int h, float lb, f32x4 (&st)[8], f32x4 (&oacc)[4], float& bLsum, StageRegs& R) {
    int tid = ltid();
    const int lane = tid & 63, wave = tid >> 6, r = lane & 15, kg = lane >> 4;
    LAS float* misc = (LAS float*)(lds + HG_MISC); LAS float* psum = misc; LAS float* eBL = misc + 512;
    { const int s = tid >> 3, sg8 = tid & 7;
      *(LAS u32x4*)(lds + HG_K1 + s * 272 + sg8 * 32) = R.a0; *(LAS u32x4*)(lds + HG_K1 + s * 272 + sg8 * 32 + 16) = R.a1;
      if (OUT) { *(LAS u32x4*)(lds + HG_Q1 + s * 272 + sg8 * 32) = R.b0; *(LAS u32x4*)(lds + HG_Q1 + s * 272 + sg8 * 32 + 16) = R.b1; }
      stage_vT64(lds, tid, R.v0, R.v1);
      if (rbn >= 0) hg_fetch<DIR, OUT>(a, rbn, h, R); }
    __syncthreads();
    { const int c = tid & 127, part = tid >> 7;
      float sm = 0.f; float sgv[16], lfv[16];
#pragma unroll
      for (int i = 0; i < 16; ++i) { const int u = part * 16 + i, t = DIR ? 63 - u : u; const float z = bf2f(((const LAS bf16_t*)(lds + HG_K1))[t * 136 + c]); sgv[i] = sigm(z); lfv[i] = __logf(lb + (1.f - lb) * sgv[i]); sm += lfv[i]; }
      psum[part * 128 + c] = sm;
      __syncthreads();
      const float p0 = psum[c], p1 = psum[128 + c], p2 = psum[256 + c], p3 = psum[384 + c];
      const float ref = p0 + p1, bL = p0 + p1 + p2 + p3;
      float run = part == 0 ? 0.f : (part == 1 ? p0 : (part == 2 ? p0 + p1 : p0 + p1 + p2));
      if (part == 0) eBL[c] = __expf(bL);
      bLsum += bL;
      const float ebr = __expf(bL - ref);
#pragma unroll
      for (int i = 0; i < 16; ++i) { const int u = part * 16 + i, t = DIR ? 63 - u : u;
          run += lfv[i]; const float kk = (1.f - lb) * (1.f - sgv[i]);
          if (OUT) { const float qv = bf2f(((const LAS bf16_t*)(lds + HG_Q1))[t * 136 + c]);
              const float er = __expf(run - ref); const float kr = kk * __builtin_amdgcn_rcpf(er);
              ((LAS bf16_t*)(lds + HG_Q1))[t * 136 + c] = f2bf(qv * er);
              ((LAS bf16_t*)(lds + HG_K1))[t * 136 + c] = f2bf(kr);
              ((LAS bf16_t*)(lds + HG_KST))[c * 72 + t] = f2bf(kr * ebr); }
          else ((LAS bf16_t*)(lds + HG_KST))[c * 72 + t] = f2bf(kk * __expf(bL - run)); }
      if (OUT) {
#pragma unroll
          for (int n = 0; n < 8; ++n) { const int dk = n * 16 + r; const float e = __expf(psum[dk] + psum[128 + dk]);
#pragma unroll
              for (int jj = 0; jj < 4; ++jj) ((LAS bf16_t*)(lds + HG_ST))[(wave * 16 + kg * 4 + jj) * 136 + dk] = f2bf(st[n][jj] * e); } }
    }
    __syncthreads();
    if (OUT) {
        { const int mt = wave >> 1, n0 = (wave & 1) * 2;
          f32x4 s0 = (f32x4){0.f, 0.f, 0.f, 0.f}, s1 = s0;
#pragma unroll
          for (int ks = 0; ks < 4; ++ks) { const bf16x8 av = *(const LAS bf16x8*)(lds + HG_Q1 + (mt * 16 + r) * 272 + ks * 64 + kg * 16);
              const bf16x8 b0 = *(const LAS bf16x8*)(lds + HG_K1 + (n0 * 16 + r) * 272 + ks * 64 + kg * 16), b1 = *(const LAS bf16x8*)(lds + HG_K1 + ((n0 + 1) * 16 + r) * 272 + ks * 64 + kg * 16);
              s0 = MFMA16(av, b0, s0); s1 = MFMA16(av, b1, s1); }
#pragma unroll
          for (int jj = 0; jj < 4; ++jj) { const int t = mt * 16 + kg * 4 + jj; const int sA = n0 * 16 + r, sB = (n0 + 1) * 16 + r;
              const bool kA = DIR ? (sA >= t) : (sA <= t), kB = DIR ? (sB >= t) : (sB <= t);
              ((LAS bf16_t*)(lds + HG_PB))[t * 72 + sA] = kA ? f2bf(s0[jj]) : (bf16_t)0; ((LAS bf16_t*)(lds + HG_PB))[t * 72 + sB] = kB ? f2bf(s1[jj]) : (bf16_t)0; } }
        __syncthreads();
        { const int mt = wave >> 1, nv0 = (wave & 1) * 4;
#pragma unroll
          for (int ks2 = 0; ks2 < 2; ++ks2) { const bf16x8 av = *(const LAS bf16x8*)(lds + HG_PB + (mt * 16 + r) * 144 + ks2 * 64 + kg * 16);
#pragma unroll
              for (int i = 0; i < 4; ++i) { const bf16x8 bv = *(const LAS bf16x8*)(lds + HG_VT + ((nv0 + i) * 16 + r) * 144 + ks2 * 64 + kg * 16); oacc[i] = MFMA16(av, bv, oacc[i]); } }
#pragma unroll
          for (int ks = 0; ks < 4; ++ks) { const bf16x8 av = *(const LAS bf16x8*)(lds + HG_Q1 + (mt * 16 + r) * 272 + ks * 64 + kg * 16);
#pragma unroll
              for (int i = 0; i < 4; ++i) { const bf16x8 bv = *(const LAS bf16x8*)(lds + HG_ST + ((nv0 + i) * 16 + r) * 272 + ks * 64 + kg * 16); oacc[i] = MFMA16(av, bv, oacc[i]); } } }
    }
#pragma unroll
    for (int n = 0; n < 8; ++n) { const float e = eBL[n * 16 + r]; st[n] = st[n] * e; }
#pragma unroll
    for (int ks2 = 0; ks2 < 2; ++ks2) { const bf16x8 av = *(const LAS bf16x8*)(lds + HG_VT + (wave * 16 + r) * 144 + ks2 * 64 + kg * 16);
#pragma unroll
        for (int n = 0; n < 8; ++n) { const bf16x8 bv = *(const LAS bf16x8*)(lds + HG_KST + (n * 16 + r) * 144 + ks2 * 64 + kg * 16); st[n] = MFMA16(av, bv, st[n]); } }
    __syncthreads();
}

__device__ __forceinline__ float hg_lb(const Args& a, int dir, int h, int c) {
    const float l0 = a.lb_logits[(dir * 2 + 0) * 512 + h * 128 + c], l1 = a.lb_logits[(dir * 2 + 1) * 512 + h * 128 + c]; return __builtin_amdgcn_rcpf(1.f + __expf(l1 - l0)); }

__device__ void m1_hg_item(const Args& a, LAS unsigned char* lds, int rowbase, int h, int seqF, int slotF, int slotB) {
    const int tid = ltid(), lane = tid & 63, wave = tid >> 6, r = lane & 15, kg = lane >> 4, c = tid & 127;
    bf16_t* hgst = (bf16_t*)a.out + (size_t)1024 * 16384; float* hg_B = (float*)(a.ws + WS_SMALL + SM_HGB);
    f32x4 dummy[4]; f32x4 st[8]; StageRegs R;
    __syncthreads();
    if (slotF >= 0) {
        const float lb = hg_lb(a, 0, h, c); float bs = 0.f;
#pragma unroll
        for (int n = 0; n < 8; ++n) st[n] = (f32x4){0.f, 0.f, 0.f, 0.f};
        hg_fetch<0, false>(a, rowbase, h, R);
#pragma unroll 1
        for (int scu = 0; scu < 4; ++scu) hg_sub<0, false>(a, lds, scu < 3 ? rowbase + (scu + 1) * 64 : -1, h, lb, st, dummy, bs, R);
        bf16_t* dst = hgst + (size_t)(seqF * 16 + slotF) * 16384;
#pragma unroll
        for (int n = 0; n < 8; ++n)
#pragma unroll
            for (int jj = 0; jj < 4; ++jj) dst[(wave * 16 + kg * 4 + jj) * 128 + n * 16 + r] = f2bf(st[n][jj]);
        if (tid < 128) hg_B[(size_t)(seqF * 16 + slotF) * 128 + c] = bs;
    }
    if (slotB >= 0) {
        const float lb = hg_lb(a, 1, h, c); float bs = 0.f;
#pragma unroll
        for (int n = 0; n < 8; ++n) st[n] = (f32x4){0.f, 0.f, 0.f, 0.f};
        hg_fetch<1, false>(a, rowbase + 192, h, R);
#pragma unroll 1
        for (int scu = 0; scu < 4; ++scu) hg_sub<1, false>(a, lds, scu < 3 ? rowbase + (2 - scu) * 64 : -1, h, lb, st, dummy, bs, R);
        bf16_t* dst = hgst + (size_t)((seqF + 1) * 16 + slotB) * 16384;
#pragma unroll
        for (int n = 0; n < 8; ++n)
#pragma unroll
            for (int jj = 0; jj < 4; ++jj) dst[(wave * 16 + kg * 4 + jj) * 128 + n * 16 + r] = f2bf(st[n][jj]);
        if (tid < 128) hg_B[(size_t)((seqF + 1) * 16 + slotB) * 128 + c] = bs;
    }
}

__device__ void m3_hg_item(const Args& a, LAS unsigned char* lds, int q) {
    const int tid = ltid(), lane = tid & 63, wave = tid >> 6, r = lane & 15, kg = lane >> 4;
    const int b = q >> 6, h = (q >> 4) & 3, j = (q & 15) + 1;
    const int rowbase = b * 4096 + (j - 1) * 256;
    const bf16_t* P = (const bf16_t*)(a.ws + WS_P);
    const bf16_t* hgst = (const bf16_t*)a.out + (size_t)1024 * 16384;
    bf16_t* Y = (bf16_t*)(a.ws + WS_Y);
    const int seqF = (b * 4 + h) * 2, seqB = seqF + 1;
    const int slF = seqF * 16 + (j - 1), slB = seqB * 16 + (16 - j);
    const int c = tid & 127;
    const int mt = wave >> 1, hv = wave & 1;
    f32x4 st[8]; float bs = 0.f; StageRegs R;
    __syncthreads();
    {
        const float lb = hg_lb(a, 0, h, c);
        hg_fetch<0, true>(a, rowbase, h, R);
        const bf16_t* sp = hgst + (size_t)slF * 16384;
#pragma unroll
        for (int n = 0; n < 8; ++n)
#pragma unroll
            for (int jj = 0; jj < 4; ++jj) st[n][jj] = bf2f(sp[(wave * 16 + kg * 4 + jj) * 128 + n * 16 + r]);
#pragma unroll 1
        for (int scu = 0; scu < 4; ++scu) {
            f32x4 o[4];
#pragma unroll
            for (int i = 0; i < 4; ++i) o[i] = (f32x4){0.f, 0.f, 0.f, 0.f};
            const int rb = rowbase + scu * 64;
            hg_sub<0, true>(a, lds, scu < 3 ? rb + 64 : -1, h, lb, st, o, bs, R);
            { u32x4* pk = (u32x4*)(a.ws + WS_PARK + (size_t)lbid() * 65536) + (scu * NT + tid) * 2;
              pk[0] = (u32x4){pack2(o[0][0], o[0][1]), pack2(o[0][2], o[0][3]), pack2(o[1][0], o[1][1]), pack2(o[1][2], o[1][3])};
              pk[1] = (u32x4){pack2(o[2][0], o[2][1]), pack2(o[2][2], o[2][3]), pack2(o[3][0], o[3][1]), pack2(o[3][2], o[3][3])}; }
        }
    }
    {
        const float lb = hg_lb(a, 1, h, c);
        hg_fetch<1, true>(a, rowbase + 192, h, R);
        const bf16_t* sp = hgst + (size_t)slB * 16384;
        LAS float* ssq = (LAS float*)(lds + HG_MISC) + 1024;
#pragma unroll
        for (int n = 0; n < 8; ++n)
#pragma unroll
            for (int jj = 0; jj < 4; ++jj) st[n][jj] = bf2f(sp[(wave * 16 + kg * 4 + jj) * 128 + n * 16 + r]);
#pragma unroll 1
        for (int scu = 0; scu < 4; ++scu) {
            f32x4 o[4];
#pragma unroll
            for (int i = 0; i < 4; ++i) o[i] = (f32x4){0.f, 0.f, 0.f, 0.f};
            const int rb = rowbase + (3 - scu) * 64;
            hg_sub<1, true>(a, lds, scu < 3 ? rb - 64 : -1, h, lb, st, o, bs, R);
            const u32x4* pkp = (const u32x4*)(a.ws + WS_PARK + (size_t)lbid() * 65536) + ((3 - scu) * NT + tid) * 2; const u32x4 pk0 = pkp[0], pk1 = pkp[1];
#pragma unroll
            for (int jj = 0; jj < 4; ++jj) { float ss = 0.f;
#pragma unroll
                for (int i = 0; i < 4; ++i) { const unsigned pw = (i < 2 ? pk0 : pk1)[(i & 1) * 2 + (jj >> 1)]; const float v = o[i][jj] + ((jj & 1) ? hi_f(pw) : lo_f(pw)); o[i][jj] = v; ss += v * v; }
                ss = red16(ss); if (r == 0) ssq[(mt * 16 + kg * 4 + jj) * 2 + hv] = ss; }
            __syncthreads();
#pragma unroll
            for (int jj = 0; jj < 4; ++jj) { const int t = mt * 16 + kg * 4 + jj; const float rs = rsqrtf((ssq[t * 2] + ssq[t * 2 + 1]) * (1.f / 128.f) + 1e-6f);
#pragma unroll
                for (int i = 0; i < 4; ++i) { const int col = h * 128 + hv * 64 + i * 16 + r; const float g = bf2f(P[(size_t)(rb + t) * NPC + 4096 + col]);
                    Y[(size_t)(rb + t) * 1024 + 512 + col] = f2bf(o[i][jj] * rs * a.hg_norm_w[col] * g); } }
        }
    }
}

template <int DIR>
__device__ __forceinline__ void ml_fetch(const Args& a, int rb, int h, StageRegs& R) {
    const int tid = ltid(); const bf16_t* P = (const bf16_t*)(a.ws + WS_P); const bf16_t* QK = (const bf16_t*)(a.ws + WS_R1); const float* gates = (const float*)(a.ws + WS_GATES);
    const int s = tid >> 3, sg8 = tid & 7; const bf16_t* qp = QK + (size_t)(rb + s) * 1024 + h * 128 + sg8 * 16;
    R.b0 = *(const u32x4*)qp; R.b1 = *(const u32x4*)(qp + 8); R.a0 = *(const u32x4*)(qp + 512); R.a1 = *(const u32x4*)(qp + 520);
    const int s2 = tid & 63, cp = tid >> 6; const bf16_t* vp = P + (size_t)(rb + s2) * NPC + 1024 + h * 128 + cp * 16;
    R.v0 = *(const u32x4*)vp; R.v1 = *(const u32x4*)(vp + 8);
    if (tid < 64) { const float* g = gates + (size_t)(rb + tid) * 16; R.g0 = g[(DIR ? 12 : 4) + h]; R.g1 = g[(DIR ? 8 : 0) + h]; }
}
template <int DIR>
__device__ __forceinline__ void ml_sub(const Args& a, LAS unsigned char* lds, int rbn, int h, f32x4 (&st)[8], f32x4 (&hout)[4], StageRegs& R) {
    const int tid = ltid(), lane = tid & 63, wave = tid >> 6, r = lane & 15, kg = lane >> 4;
    LAS float* mf = (LAS float*)(lds + HG_MISC);
    LAS float *psum = mf, *nS = mf + 512, *lfA = mf + 640, *igA = mf + 704, *cA = mf + 768, *MA = mf + 832, *wiA = mf + 896, *flA = mf + 960, *wsA = mf + 1024, *scal = mf + 1088, *denP = mf + 1104, *qnP = mf + 1232;
    { const int s = tid >> 3, sg8 = tid & 7;
      *(LAS u32x4*)(lds + HG_Q1 + s * 272 + sg8 * 32) = R.b0; *(LAS u32x4*)(lds + HG_Q1 + s * 272 + sg8 * 32 + 16) = R.b1;
      *(LAS u32x4*)(lds + HG_K1 + s * 272 + sg8 * 32) = R.a0; *(LAS u32x4*)(lds + HG_K1 + s * 272 + sg8 * 32 + 16) = R.a1;
      stage_vT64(lds, tid, R.v0, R.v1);
      if (tid < 64) { lfA[tid] = logsig(R.g0); igA[tid] = R.g1; }
      if (rbn >= 0) ml_fetch<DIR>(a, rbn, h, R); }
    __syncthreads();
    if (tid < 64) { const int t = DIR ? 63 - lane : lane;
        const float l = lfA[t], ig = igA[t];
        const float b = wscan_add(l, lane); const float c = ig - b; const float gmx = wscan_max(c, lane);
        const float mprev = scal[1]; const float M = fmaxf(mprev, gmx);
        const float Btot = __shfl(b, 63), cmax = __shfl(gmx, 63); const float Mall = fmaxf(mprev, cmax);
        cA[t] = c; MA[t] = M; wiA[t] = __expf(mprev - M); flA[t] = __expf(-b - M); wsA[t] = __expf(c - Mall);
        if (lane == 0) { scal[0] = __expf(mprev - Mall); scal[2] = Btot + Mall; } }
    __syncthreads();
    { const int mt = wave >> 1, n0 = (wave & 1) * 2;
      f32x4 s0 = (f32x4){0.f, 0.f, 0.f, 0.f}, s1 = s0;
#pragma unroll
      for (int ks = 0; ks < 4; ++ks) { const bf16x8 av = *(const LAS bf16x8*)(lds + HG_Q1 + (mt * 16 + r) * 272 + ks * 64 + kg * 16);
          const bf16x8 b0 = *(const LAS bf16x8*)(lds + HG_K1 + (n0 * 16 + r) * 272 + ks * 64 + kg * 16), b1 = *(const LAS bf16x8*)(lds + HG_K1 + ((n0 + 1) * 16 + r) * 272 + ks * 64 + kg * 16);
          s0 = MFMA16(av, b0, s0); s1 = MFMA16(av, b1, s1); }
      const int sA = n0 * 16 + r, sB = sA + 16; const float cAv = cA[sA], cBv = cA[sB];
#pragma unroll
      for (int jj = 0; jj < 4; ++jj) { const int t = mt * 16 + kg * 4 + jj; const float Mt = MA[t];
          const bool kA = DIR ? (sA >= t) : (sA <= t), kB = DIR ? (sB >= t) : (sB <= t);
          const float pA = kA ? s0[jj] * __expf(cAv - Mt) : 0.f, pB = kB ? s1[jj] * __expf(cBv - Mt) : 0.f;
          ((LAS bf16_t*)(lds + HG_PB))[t * 72 + sA] = f2bf(pA); ((LAS bf16_t*)(lds + HG_PB))[t * 72 + sB] = f2bf(pB);
          const float ds = red16(pA + pB); if (r == 0) denP[t * 2 + (wave & 1)] = ds; } }
    { const int c = tid & 127, part = tid >> 7; float sm = 0.f;
#pragma unroll 4
      for (int i = 0; i < 16; ++i) { const int t = part * 16 + i; const float kw = bf2f(((const LAS bf16_t*)(lds + HG_K1))[t * 136 + c]) * wsA[t];
          ((LAS bf16_t*)(lds + HG_KST))[c * 72 + t] = f2bf(kw); sm += kw; }
      psum[part * 128 + c] = sm; }
    { const int t = tid & 63, p8 = tid >> 6; float acc = 0.f;
#pragma unroll 4
      for (int i = 0; i < 16; ++i) { const int dk = p8 * 16 + i; acc += bf2f(((const LAS bf16_t*)(lds + HG_Q1))[t * 136 + dk]) * nS[dk]; }
      qnP[p8 * 64 + t] = acc; }
#pragma unroll
    for (int n = 0; n < 8; ++n)
#pragma unroll
        for (int jj = 0; jj < 4; ++jj) ((LAS bf16_t*)(lds + HG_ST))[(wave * 16 + kg * 4 + jj) * 136 + n * 16 + r] = f2bf(st[n][jj]);
    __syncthreads();
    { const int mt = wave >> 1, nv0 = (wave & 1) * 4;
      f32x4 o1[4], o2[4];
#pragma unroll
      for (int i = 0; i < 4; ++i) { o1[i] = (f32x4){0.f, 0.f, 0.f, 0.f}; o2[i] = o1[i]; }
#pragma unroll
      for (int ks2 = 0; ks2 < 2; ++ks2) { const bf16x8 av = *(const LAS bf16x8*)(lds + HG_PB + (mt * 16 + r) * 144 + ks2 * 64 + kg * 16);
#pragma unroll
          for (int i = 0; i < 4; ++i) { const bf16x8 bv = *(const LAS bf16x8*)(lds + HG_VT + ((nv0 + i) * 16 + r) * 144 + ks2 * 64 + kg * 16); o1[i] = MFMA16(av, bv, o1[i]); } }
#pragma unroll
      for (int ks = 0; ks < 4; ++ks) { const bf16x8 av = *(const LAS bf16x8*)(lds + HG_Q1 + (mt * 16 + r) * 272 + ks * 64 + kg * 16);
#pragma unroll
          for (int i = 0; i < 4; ++i) { const bf16x8 bv = *(const LAS bf16x8*)(lds + HG_ST + ((nv0 + i) * 16 + r) * 272 + ks * 64 + kg * 16); o2[i] = MFMA16(av, bv, o2[i]); } }
#pragma unroll
      for (int jj = 0; jj < 4; ++jj) { const int t = mt * 16 + kg * 4 + jj; const float wi = wiA[t];
          float qn = 0.f;
#pragma unroll
          for (int p8 = 0; p8 < 8; ++p8) qn += qnP[p8 * 64 + t];
          const float den = denP[t * 2] + denP[t * 2 + 1] + wi * qn; const float inv = __builtin_amdgcn_rcpf(fmaxf(fabsf(den), flA[t]));
#pragma unroll
          for (int i = 0; i < 4; ++i) hout[i][jj] = (o1[i][jj] + wi * o2[i][jj]) * inv; } }
    const float decay = scal[0];
#pragma unroll
    for (int n = 0; n < 8; ++n) st[n] = st[n] * decay;
#pragma unroll
    for (int ks2 = 0; ks2 < 2; ++ks2) { const bf16x8 av = *(const LAS bf16x8*)(lds + HG_VT + (wave * 16 + r) * 144 + ks2 * 64 + kg * 16);
#pragma unroll
        for (int n = 0; n < 8; ++n) { const bf16x8 bv = *(const LAS bf16x8*)(lds + HG_KST + (n * 16 + r) * 144 + ks2 * 64 + kg * 16); st[n] = MFMA16(av, bv, st[n]); } }
    __syncthreads();
    if (tid < 128) nS[tid] = decay * nS[tid] + psum[tid] + psum[128 + tid] + psum[256 + tid] + psum[384 + tid];
    if (tid == 0) scal[1] = scal[2];
}

__device__ void m3_ml2_item(const Args& a, LAS unsigned char* lds, int q) {
    const int tid = ltid(), lane = tid & 63, wave = tid >> 6, r = lane & 15, kg = lane >> 4;
    const int b = q >> 6, h = (q >> 4) & 3, j = (q & 15) + 1;
    const int rowbase = b * 4096 + (j - 1) * 256;
    const bf16_t* P = (const bf16_t*)(a.ws + WS_P);
    const bf16_t* mlst = (const bf16_t*)a.out;
    const float* ml_n = (const float*)(a.ws + WS_SMALL + SM_MLN); const float* ml_mpre = (const float*)(a.ws + WS_SMALL + SM_MPRE);
    bf16_t* Y = (bf16_t*)(a.ws + WS_Y);
    LAS float* mf = (LAS float*)(lds + HG_MISC); LAS float *nS = mf + 512, *scal = mf + 1088, *ssq = mf + 1744;
    const int seqF = (b * 4 + h) * 2, seqB = seqF + 1;
    const int slF = seqF * 16 + (j - 1), slB = seqB * 16 + (16 - j);
    const int mt = wave >> 1, hv = wave & 1;
    f32x4 st[8]; StageRegs R;
    __syncthreads();
    {
        const bf16_t* sp = mlst + (size_t)slF * 16384;
#pragma unroll
        for (int n = 0; n < 8; ++n)
#pragma unroll
            for (int jj = 0; jj < 4; ++jj) st[n][jj] = bf2f(sp[(wave * 16 + kg * 4 + jj) * 128 + n * 16 + r]);
        if (tid < 128) nS[tid] = ml_n[(size_t)slF * 128 + tid];
        if (tid == 0) scal[1] = ml_mpre[slF];
        ml_fetch<0>(a, rowbase, h, R);
#pragma unroll 1
        for (int scu = 0; scu < 4; ++scu) { f32x4 ho[4]; const int rb = rowbase + scu * 64;
            ml_sub<0>(a, lds, scu < 3 ? rb + 64 : -1, h, st, ho, R);
            { u32x4* pk = (u32x4*)(a.ws + WS_PARK + (size_t)lbid() * 65536) + (scu * NT + tid) * 2;
              pk[0] = (u32x4){pack2(ho[0][0], ho[0][1]), pack2(ho[0][2], ho[0][3]), pack2(ho[1][0], ho[1][1]), pack2(ho[1][2], ho[1][3])};
              pk[1] = (u32x4){pack2(ho[2][0], ho[2][1]), pack2(ho[2][2], ho[2][3]), pack2(ho[3][0], ho[3][1]), pack2(ho[3][2], ho[3][3])}; } }
    }
    {
        const bf16_t* sp = mlst + (size_t)slB * 16384;
#pragma unroll
        for (int n = 0; n < 8; ++n)
#pragma unroll
            for (int jj = 0; jj < 4; ++jj) st[n][jj] = bf2f(sp[(wave * 16 + kg * 4 + jj) * 128 + n * 16 + r]);
        if (tid < 128) nS[tid] = ml_n[(size_t)slB * 128 + tid];
        if (tid == 0) scal[1] = ml_mpre[slB];
        ml_fetch<1>(a, rowbase + 192, h, R);
#pragma unroll 1
        for (int scu = 0; scu < 4; ++scu) { f32x4 ho[4]; const int rb = rowbase + (3 - scu) * 64;
            ml_sub<1>(a, lds, scu < 3 ? rb - 64 : -1, h, st, ho, R);
            const u32x4* pkp = (const u32x4*)(a.ws + WS_PARK + (size_t)lbid() * 65536) + ((3 - scu) * NT + tid) * 2; const u32x4 pk0 = pkp[0], pk1 = pkp[1];
#pragma unroll
            for (int jj = 0; jj < 4; ++jj) { float ss = 0.f;
#pragma unroll
                for (int i = 0; i < 4; ++i) { const unsigned pw = (i < 2 ? pk0 : pk1)[(i & 1) * 2 + (jj >> 1)]; const float v = ho[i][jj] + ((jj & 1) ? hi_f(pw) : lo_f(pw)); ho[i][jj] = v; ss += v * v; }
                ss = red16(ss); if (r == 0) ssq[(mt * 16 + kg * 4 + jj) * 2 + hv] = ss; }
            __syncthreads();
#pragma unroll
            for (int jj = 0; jj < 4; ++jj) { const int t = mt * 16 + kg * 4 + jj; const float rs = rsqrtf((ssq[t * 2] + ssq[t * 2 + 1]) * (1.f / 128.f) + 1e-6f);
#pragma unroll
                for (int i = 0; i < 4; ++i) { const int col = h * 128 + hv * 64 + i * 16 + r; const float og = bf2f(P[(size_t)(rb + t) * NPC + 1536 + col]);
                    Y[(size_t)(rb + t) * 1024 + col] = f2bf(ho[i][jj] * rs * a.ml_norm_w[col] * og); } }
        }
    }
}

__device__ void phase_m3(const Args& a, LAS unsigned char* lds) {
    for (int it = lbid(); it < 1024; it += gridDim.x) {
        if (it < 512) m3_ml2_item(a, lds, it); else m3_hg_item(a, lds, it - 512);
    }
}

#define XB_TMO      128
#define XB_XCNT(j)  (256  + 64 * (j))
#define XB_XSUB(j)  (1280 + 64 * (j))
#define XB_XGEN(j)  (2304 + 64 * (j))
#define XB_TOP      3328
#define XB_TOPGEN   3392
#define XCD_BAR_WORDS 3456
#define XB_SPIN_CAP (1u << 18)
__device__ __forceinline__ unsigned xb_ld(unsigned* p)              { return __hip_atomic_load(p, __ATOMIC_RELAXED, __HIP_MEMORY_SCOPE_AGENT); }
__device__ __forceinline__ unsigned xb_add(unsigned* p, unsigned v) { return __hip_atomic_fetch_add(p, v, __ATOMIC_RELAXED, __HIP_MEMORY_SCOPE_AGENT); }
__device__ __forceinline__ unsigned xb_xcc_id() { return (unsigned)__builtin_amdgcn_s_getreg((3 << 11) | 20) & 0xFu; }
#define XB_SPIN(cond, bar) do { unsigned _sp = 0; while (cond) { __builtin_amdgcn_s_sleep(1); \
    if ((++_sp & 255u) == 0u) { if (xb_ld(&(bar)[XB_TMO])) break; if (_sp > XB_SPIN_CAP) { atomicAdd(&(bar)[XB_TMO], 1u); break; } } } } while (0)
struct XcdBarrier { unsigned* bar; unsigned x; volatile LAS unsigned* st; };
__device__ __forceinline__ XcdBarrier xcd_barrier_post(unsigned* bar, volatile LAS unsigned* st) {
    XcdBarrier b; b.bar = bar; b.x = xb_xcc_id(); b.st = st;
    if (threadIdx.x == 0) (void)xb_add(&bar[XB_XCNT(b.x)], 1u);
    return b;
}
__device__ __forceinline__ void xcd_barrier_complete(unsigned* bar, unsigned x, unsigned& nloc, unsigned& nx) {
    const unsigned G = gridDim.x * gridDim.y * gridDim.z;
    unsigned sum, cnt, mine, sp = 0u;
    for (;;) {
        sum = 0u; cnt = 0u; mine = 0u;
#pragma unroll
        for (unsigned j = 0; j < 16; ++j) { const unsigned c = xb_ld(&bar[XB_XCNT(j)]); sum += c; cnt += (c > 0u) ? 1u : 0u; mine = (j == x) ? c : mine; }
        if (sum == G) break;
        __builtin_amdgcn_s_sleep(1);
        if ((++sp & 255u) == 0u) { if (xb_ld(&bar[XB_TMO])) break; if (sp > XB_SPIN_CAP) { atomicAdd(&bar[XB_TMO], 1u); break; } }
    }
    nloc = mine > 0u ? mine : 1u; nx = cnt > 0u ? cnt : 1u;
}
__device__ __forceinline__ void xcd_barrier(const XcdBarrier& b) {
    asm volatile("s_waitcnt vmcnt(0)" ::: "memory");
    __syncthreads();
    if (threadIdx.x == 0) {
        unsigned* bar = b.bar;
        __builtin_amdgcn_s_waitcnt(0);
        unsigned nloc = b.st[0], nx = b.st[1];
        if (nloc == 0u) { xcd_barrier_complete(bar, b.x, nloc, nx); b.st[0] = nloc; b.st[1] = nx; }
        const unsigned old = xb_add(&bar[XB_XSUB(b.x)], 1u);
        const unsigned gen = old / nloc;
        if (old + 1u == (gen + 1u) * nloc) {
            __builtin_amdgcn_fence(__ATOMIC_RELEASE, "agent");
            asm volatile("s_waitcnt vmcnt(0)" ::: "memory");
            const unsigned og = xb_add(&bar[XB_TOP], 1u);
            const unsigned tg = og / nx;
            if (og + 1u == (tg + 1u) * nx) xb_add(&bar[XB_TOPGEN], 1u);
            else XB_SPIN(xb_ld(&bar[XB_TOPGEN]) == tg, bar);
            __builtin_amdgcn_fence(__ATOMIC_ACQUIRE, "agent");
            xb_add(&bar[XB_XGEN(b.x)], 1u);
            asm volatile("s_waitcnt vmcnt(0)" ::: "memory");
        } else {
            XB_SPIN(xb_ld(&bar[XB_XGEN(b.x)]) == gen, bar);
            __builtin_amdgcn_fence(__ATOMIC_ACQUIRE, "agent");
            asm volatile("s_waitcnt vmcnt(0)" ::: "memory");
        }
    }
    __syncthreads();
}
constexpr size_t WS_BAR = WS_SMALL + 1536 * 1024;

constexpr int N_PHASES = 14;
__global__ void __launch_bounds__(NT, 2) mega(Args a) {
    extern __shared__ __attribute__((aligned(16))) unsigned char lds_raw[];
    LAS unsigned char* lds = (LAS unsigned char*)lds_raw;
    cg::grid_group grid = cg::this_grid();
    const int G = gridDim.x, bid = lbid();
    volatile LAS unsigned* stw = (volatile LAS unsigned*)(lds + LDS_BYTES - 16);
    if (threadIdx.x == 0) { stw[0] = 0u; stw[1] = 0u; }
    __syncthreads();
    const XcdBarrier bar = xcd_barrier_post((unsigned*)(a.ws + WS_BAR), stw);
    const int ph_lo = a.ph_lo, ph_hi = a.ph_hi;
    if (ph_lo < 0) grid.sync();
    for (int ph = ph_lo; ph < ph_hi; ++ph) {
        { __attribute__((address_space(1))) unsigned char* w = (__attribute__((address_space(1))) unsigned char*)a.ws; __attribute__((address_space(1))) float* o = (__attribute__((address_space(1))) float*)a.out;
          asm volatile("" : "+s"(w), "+s"(o)); a.ws = (unsigned char*)w; a.out = (float*)o; }
        switch (ph) {
        case 0: phase_p0(a, lds); break;
        case 1: phase_p1(a, lds); break;
        case 2: { pg8::Gemm g{(const bf16_t*)(a.ws + WS_R1), nullptr, 1 << 30, (const bf16_t*)(a.ws + WS_WIN), NROWS, NPC, 1024}; pg8::StaticOrder S; S.init(NROWS, NPC, G, bid);
                  pg8::EpiBf16<true> E{(bf16_t*)(a.ws + WS_P), NPC}; pg8::gemm_phase(lds, g, S, E); } break;
        case 3: phase_mc(a); break;
        case 4: phase_m1(a, lds); break;
        case 5: phase_m2(a); break;
        case 6: phase_m3(a, lds); break;
        case 7: { pg8::Gemm g{(const bf16_t*)(a.ws + WS_Y), nullptr, 1 << 30, (const bf16_t*)(a.ws + WS_WOUT), NLAT, 1024, 1024}; pg8::StaticOrder S; S.init(NLAT, 1024, G, bid);
                  pg8::EpiRes E{a.x, a.out, (const float*)(a.ws + WS_MOD) + 2048}; pg8::gemm_phase(lds, g, S, E); } break;
        case 8: phase_n2(a); break;
        case 9: { pg8::Gemm g{(const bf16_t*)(a.ws + WS_A2), nullptr, 1 << 30, (const bf16_t*)(a.ws + WS_WUP), NLAT, 5632, 1024}; pg8::StaticOrder S; S.init(NLAT, 5632, G, bid);
                  pg8::EpiBf16<false> E{(bf16_t*)(a.ws + WS_U), 5632}; pg8::gemm_phase(lds, g, S, E); } break;
        case 10: phase_cv(a, 0, (bf16_t*)(a.ws + WS_ACTA)); break;
        case 11: phase_cv(a, 4, (bf16_t*)(a.ws + WS_ACTB)); break;
        case 12: { pg8::Gemm g{(const bf16_t*)(a.ws + WS_ACTA), (const bf16_t*)(a.ws + WS_ACTB), 64, (const bf16_t*)(a.ws + WS_WDN), NLAT, 1024, 2816}; pg8::StaticOrder S; S.init(NLAT, 1024, G, bid);
                  pg8::EpiRes E{a.out, a.out, (const float*)(a.ws + WS_MOD) + 5120}; pg8::gemm_phase(lds, g, S, E); } break;
        case 13: phase_fn(a); break;
        }
        if (ph + 1 < ph_hi) xcd_barrier(bar);
    }
}

extern "C" void kernel_launch(void* const* d_in, const int* in_sizes, int n_in, void* d_out, int out_size, void* d_ws, size_t ws_size, hipStream_t stream) {
    static int grid = 0;
    if (grid == 0) {
        if (n_in != 19 || ws_size < WS_NEED) { fprintf(stderr, "kernel_launch: unexpected n_in %d / ws_size %zu\n", n_in, ws_size); grid = -1; return; }
        int dev = 0, cus = 0, per_cu = 0;
        (void)hipGetDevice(&dev); (void)hipDeviceGetAttribute(&cus, hipDeviceAttributeMultiprocessorCount, dev);
        if (hipFuncSetAttribute((const void*)mega, hipFuncAttributeMaxDynamicSharedMemorySize, LDS_BYTES) != hipSuccess) { fprintf(stderr, "kernel_launch: hipFuncSetAttribute failed\n"); grid = -1; return; }
        if (hipOccupancyMaxActiveBlocksPerMultiprocessor(&per_cu, (const void*)mega, NT, LDS_BYTES) != hipSuccess || per_cu < 1) { fprintf(stderr, "kernel_launch: occupancy query says %d\n", per_cu); per_cu = 1; }
        (void)hipGetLastError();
        grid = cus;
    }
    if (grid < 0) return;
    Args a{};
    const float** ip = (const float**)&a;
    for (int i = 0; i < 19; ++i) ip[i] = (const float*)d_in[i];
    a.out = (float*)d_out; a.ws = (unsigned char*)d_ws;
    (void)hipMemsetAsync((unsigned char*)d_ws + WS_BAR, 0, XCD_BAR_WORDS * sizeof(unsigned), stream);
    a.ph_lo = 0; a.ph_hi = N_PHASES; void* args[] = {&a};
    hipError_t e = hipLaunchCooperativeKernel((const void*)mega, dim3(grid), dim3(NT), args, LDS_BYTES, stream);
    if (e != hipSuccess) fprintf(stderr, "cooperative launch failed: %s (grid %d)\n", hipGetErrorString(e), grid);
}
```

```cpp
#include <hip/hip_runtime.h>
#include <hip/hip_cooperative_groups.h>
#include <cstdio>
namespace cg = cooperative_groups;

#define LAS __attribute__((address_space(3)))
typedef unsigned short bf16_t;
typedef short bf16x8 __attribute__((ext_vector_type(8)));
typedef float f32x4 __attribute__((ext_vector_type(4)));
typedef float f32x2 __attribute__((ext_vector_type(2)));
typedef unsigned u32x4 __attribute__((ext_vector_type(4)));
typedef unsigned u32x2 __attribute__((ext_vector_type(2)));


constexpr int NT = 512;
constexpr int LDS_BYTES = 147456;
constexpr size_t MiB = 1048576;
constexpr int NROWS = 34816, NLAT = 32768, NPC = 4608;
constexpr size_t WS_WIN = 0, WS_WOUT = 9 * MiB, WS_WUP = 11 * MiB, WS_WDN = 22 * MiB, WS_MOD = 28 * MiB, WS_GATES = 29 * MiB, WS_SMALL = 32 * MiB;
constexpr size_t WS_R1 = 34 * MiB, WS_P = 102 * MiB, WS_Y = 408 * MiB, WS_U = 34 * MiB, WS_A2 = 448 * MiB, WS_ACTA = 386 * MiB, WS_ACTB = 34 * MiB, WS_NEED = 512 * MiB;
constexpr size_t WS_PARK = 472 * MiB;
constexpr size_t SM_MLN = 0, SM_HGB = 512 * 1024, SM_MLOC = 1024 * 1024, SM_MLB = 1024 * 1024 + 4096, SM_MPRE = 1024 * 1024 + 8192;

struct Args {
    const float *x, *c, *ctx, *c_ctx, *w_mod, *b_mod, *norm1_w, *w_in, *gate_b, *ml_conv_w, *ml_norm_w, *lb_logits, *hg_norm_w, *w_out, *norm2_w, *w_up, *ffn_conv_w, *w_down, *final_w;
    float* out; unsigned char* ws; int ph_lo, ph_hi;
};

__device__ __forceinline__ float bf2f(unsigned short h) { return __uint_as_float(((unsigned)h) << 16); }
typedef __bf16 bf16x2n __attribute__((ext_vector_type(2)));
__device__ __forceinline__ unsigned pack2(float lo, float hi) { const f32x2 v = {lo, hi}; return __builtin_bit_cast(unsigned, __builtin_convertvector(v, bf16x2n)); }
__device__ __forceinline__ unsigned short f2bf(float f) { return (unsigned short)pack2(f, f); }
__device__ __forceinline__ float lo_f(unsigned u) { return __uint_as_float(u << 16); }
__device__ __forceinline__ float hi_f(unsigned u) { return __uint_as_float(u & 0xffff0000u); }
__device__ __forceinline__ float sigm(float x) { return __builtin_amdgcn_rcpf(1.f + __expf(-x)); }
__device__ __forceinline__ float silu(float x) { return x * __builtin_amdgcn_rcpf(1.f + __expf(-x)); }
__device__ __forceinline__ float logsig(float x) { return fminf(x, 0.f) - log1pf(__expf(-fabsf(x))); }
__device__ __forceinline__ float wsum(float v) {
#pragma unroll
    for (int o = 32; o; o >>= 1) v += __shfl_xor(v, o); return v; }
__device__ __forceinline__ float wmaxr(float v) {
#pragma unroll
    for (int o = 32; o; o >>= 1) v = fmaxf(v, __shfl_xor(v, o)); return v; }
__device__ __forceinline__ float wscan_add(float v, int lane) {
#pragma unroll
    for (int o = 1; o < 64; o <<= 1) { float t = __shfl_up(v, o); if (lane >= o) v += t; } return v; }
__device__ __forceinline__ float wscan_max(float v, int lane) {
#pragma unroll
    for (int o = 1; o < 64; o <<= 1) { float t = __shfl_up(v, o); if (lane >= o) v = fmaxf(v, t); } return v; }
__device__ __forceinline__ float red16(float v) { v += __shfl_xor(v, 1); v += __shfl_xor(v, 2); v += __shfl_xor(v, 4); v += __shfl_xor(v, 8); return v; }
__device__ __forceinline__ void wave_lds_sync() { __builtin_amdgcn_fence(__ATOMIC_RELEASE, "workgroup"); __builtin_amdgcn_wave_barrier(); __builtin_amdgcn_fence(__ATOMIC_ACQUIRE, "workgroup"); }
__device__ __forceinline__ int ltid() { int t = threadIdx.x; asm volatile("" : "+v"(t)); return t; }
__device__ __forceinline__ int lbid() { int t = blockIdx.x; asm volatile("" : "+s"(t)); return t; }
#define MFMA16(a, b, c) __builtin_amdgcn_mfma_f32_16x16x32_bf16((a), (b), (c), 0, 0, 0)

namespace pg8 {
constexpr int BM = 256, BK = 64, HALF = 128, HTB = HALF * BK * 2, STAGE_BYTES = 8 * HTB, NXCD = 8, WGM = 2;
__device__ __forceinline__ int lds_byte(int r, int c) { const int st = (r >> 4) * 2 + (c >> 5), rr = r & 15, cc = c & 31, ob = rr * 64 + cc * 2; return st * 1024 + (ob ^ (((ob >> 9) & 1) << 5)); }
__device__ __forceinline__ void stage_rc(int b, int& R, int& C) { const int st = b / 1024, sb = b % 1024, swz = sb ^ (((sb >> 9) & 1) << 5); R = (st >> 1) * 16 + swz / 64; C = (st & 1) * 32 + (swz % 64) / 2; }
__device__ __forceinline__ int perm32(int rho) { const int n = rho >> 4, i = rho & 15; return 8 * (i >> 2) + 4 * n + (i & 3); }
struct Unit { int pm, pn; };
struct Gemm { const bf16_t* A; const bf16_t* A_hi; int pm_split; const bf16_t* Bt; int M, N, K; };
struct StaticOrder {
    int nM, nN, nwg, G, c;
    __device__ void init(int M, int N, int G_, int c_) { nM = M / BM; nN = N / BM; nwg = nM * nN; G = G_; c = c_; }
    __device__ bool next(int i, Unit& u) const {
        const long L = (long)i * G + c; if (L >= nwg) return false;
        int wgid = (int)L; { const int q = nwg / NXCD, r = nwg % NXCD, xcd = wgid % NXCD, off = wgid / NXCD; wgid = (xcd < r ? xcd * (q + 1) : r * (q + 1) + (xcd - r) * q) + off; }
        const int nig = WGM * nN, gid = wgid / nig, fm = gid * WGM, gsz = (nM - fm) < WGM ? (nM - fm) : WGM;
        u.pm = fm + ((wgid % nig) % gsz); u.pn = (wgid % nig) / gsz; return true;
    }
};
__device__ __forceinline__ unsigned cvt_pk_bf16(float lo, float hi) { return pack2(lo, hi); }

template <bool ACT> struct EpiBf16 {
    static constexpr bool PERM = true;
    bf16_t* O; int ldc;
    __device__ __forceinline__ f32x4 act(f32x4 v, int mode) const {
        if (!ACT || mode == 0) return v;
        f32x4 o;
#pragma unroll
        for (int j = 0; j < 4; ++j) { const float s = __builtin_amdgcn_rcpf(1.f + __expf(-v[j])); o[j] = mode == 1 ? s : (mode == 2 ? v[j] * s * 0.08838834764831845f : v[j] * s); }
        return o; }
    __device__ __forceinline__ void operator()(const f32x4 (&acc)[2][2][4][2], const Unit& u, int wr, int wc, int fr, int fq) const {
        const int mode = !ACT ? 0 : ((u.pn == 6 || u.pn == 7) ? 1 : ((u.pn == 8 || u.pn == 9) ? 2 : ((u.pn == 16 || u.pn == 17) ? 3 : 0)));
        const int row0 = u.pm * BM + wr * 64 + fr; const int col0 = u.pn * BM + wc * 32 + 8 * fq;
#pragma unroll
        for (int ai = 0; ai < 2; ++ai)
#pragma unroll
            for (int m = 0; m < 4; ++m) { bf16_t* rowp = O + (size_t)(row0 + ai * HALF + m * 16) * ldc + col0;
#pragma unroll
                for (int bj = 0; bj < 2; ++bj) { const f32x4 v0 = act(acc[ai][bj][m][0], mode), v1 = act(acc[ai][bj][m][1], mode);
                    u32x4 w; w.x = cvt_pk_bf16(v0[0], v0[1]); w.y = cvt_pk_bf16(v0[2], v0[3]); w.z = cvt_pk_bf16(v1[0], v1[1]); w.w = cvt_pk_bf16(v1[2], v1[3]);
                    __builtin_nontemporal_store(w, (u32x4*)(rowp + bj * HALF)); } }
    }
};
struct EpiRes {
    static constexpr bool PERM = false;
    const float* base; float* out; const float* gate;
    __device__ __forceinline__ void operator()(const f32x4 (&acc)[2][2][4][2], const Unit& u, int wr, int wc, int fr, int fq) const {
        const int row0 = u.pm * BM + wr * 64 + fr, col0 = u.pn * BM + wc * 32 + 4 * fq;
        const float* gp = gate + (size_t)(u.pm >> 4) * 6144 + col0;
        f32x4 gv[2][2];
#pragma unroll
        for (int bj = 0; bj < 2; ++bj)
#pragma unroll
            for (int n = 0; n < 2; ++n) gv[bj][n] = *(const f32x4*)(gp + bj * HALF + n * 16);
#pragma unroll
        for (int ai = 0; ai < 2; ++ai)
#pragma unroll
            for (int m = 0; m < 4; ++m) { const size_t ro = (size_t)(row0 + ai * HALF + m * 16) * 1024 + col0;
#pragma unroll
                for (int bj = 0; bj < 2; ++bj)
#pragma unroll
                    for (int n = 0; n < 2; ++n) { f32x4 b = *(const f32x4*)(base + ro + bj * HALF + n * 16); __builtin_nontemporal_store(b + gv[bj][n] * acc[ai][bj][m][n], (f32x4*)(out + ro + bj * HALF + n * 16)); } }
    }
};

template <class Epi, bool ALIGN_EPI = true, bool SP2 = true>
__device__ __forceinline__ void gemm_phase(LAS unsigned char* lds, const Gemm g, const StaticOrder& S, const Epi& E) {
    const int tid = ltid(), wid = __builtin_amdgcn_readfirstlane(tid >> 6), lane = tid & 63, wr = wid >> 2, wc = wid & 3, fr = lane & 15, fq = lane >> 4;
    const int K = g.K, nt = K / BK;
    unsigned voffA[2], voffB[2];
#pragma unroll
    for (int i = 0; i < 2; ++i) { int R, C; stage_rc(tid * 16 + i * 8192, R, C); const int Rb = Epi::PERM ? ((R & ~31) + perm32(R & 31)) : R;
        voffA[i] = (unsigned)(R * K + C) * 2u; voffB[i] = (unsigned)(Rb * K + C) * 2u; }
    const size_t kstep = (size_t)(BK * 2);
    const size_t hstep = (size_t)HALF * K * 2;
    const size_t tstep = 2 * hstep;
    const unsigned ldsw = (unsigned)wid * 1024u;
    const int aoff = lds_byte(wr * 64 + fr, fq * 8), boff = lds_byte(wc * 32 + fr, fq * 8);
#define PG8_APTR(pm) ((pm) < g.pm_split ? (const char*)g.A + (size_t)(pm) * tstep : (const char*)g.A_hi + (size_t)((pm) - g.pm_split) * tstep)
#define PG8_SA(b, h) (((b) * 2 + (h)) * HTB)
#define PG8_SB(b, h) ((4 + (b) * 2 + (h)) * HTB)
#define PG8_STAGE(bufoff, gbase, voff) do { _Pragma("unroll") for (int _i = 0; _i < 2; ++_i) \
        __builtin_amdgcn_global_load_lds((const unsigned*)((const char*)(gbase) + (voff)[_i]), (LAS unsigned*)(lds + (bufoff) + ldsw + _i * 8192), 16, 0, 0); } while (0)
#define PG8_LDA(dst, b, h) do { _Pragma("unroll") for (int m = 0; m < 4; ++m) _Pragma("unroll") for (int k = 0; k < 2; ++k) dst[m][k] = *(const LAS bf16x8*)(lds + PG8_SA(b, h) + aoff + m * 2048 + k * 1024); } while (0)
#define PG8_LDB(dst, b, h) do { _Pragma("unroll") for (int n = 0; n < 2; ++n) _Pragma("unroll") for (int k = 0; k < 2; ++k) dst[n][k] = *(const LAS bf16x8*)(lds + PG8_SB(b, h) + boff + n * 2048 + k * 1024); } while (0)
#define PG8_MMA(ai, bj, At, Bt) do { __builtin_amdgcn_s_setprio(1); _Pragma("unroll") for (int m = 0; m < 4; ++m) _Pragma("unroll") for (int n = 0; n < 2; ++n) _Pragma("unroll") for (int k = 0; k < 2; ++k) \
        acc[ai][bj][m][n] = __builtin_amdgcn_mfma_f32_16x16x32_bf16(Bt[n][k], At[m][k], acc[ai][bj][m][n], 0, 0, 0); __builtin_amdgcn_s_setprio(0); } while (0)
#define PG8_WAIT_V(n) asm volatile("s_waitcnt vmcnt(" #n ")" ::: "memory")
#define PG8_WAIT_L(n) asm volatile("s_waitcnt lgkmcnt(" #n ")" ::: "memory")
#define PG8_BAR __builtin_amdgcn_s_barrier()
#define PG8_SCHED __builtin_amdgcn_sched_barrier(0)
    Unit cur, nxt; int ui = 0;
    if (!S.next(0, cur)) return;
    f32x4 acc[2][2][4][2];
#pragma unroll
    for (int a = 0; a < 2; ++a)
#pragma unroll
        for (int b = 0; b < 2; ++b)
#pragma unroll
            for (int m = 0; m < 4; ++m)
#pragma unroll
                for (int n = 0; n < 2; ++n) acc[a][b][m][n] = (f32x4){0.f, 0.f, 0.f, 0.f};
    bf16x8 At[4][2], B0[2][2], B1[2][2];
    const char* cA = PG8_APTR(cur.pm); const char* cB = (const char*)g.Bt + (size_t)cur.pn * tstep;
    if constexpr (SP2) {
        PG8_STAGE(PG8_SB(0, 0), cB, voffB); PG8_STAGE(PG8_SB(0, 1), cB + hstep, voffB); PG8_STAGE(PG8_SA(0, 0), cA, voffA); PG8_STAGE(PG8_SA(0, 1), cA + hstep, voffA);
        if (wr == 1) PG8_BAR;
        PG8_WAIT_V(2); PG8_BAR;
        PG8_STAGE(PG8_SB(1, 0), cB + kstep, voffB); PG8_STAGE(PG8_SA(1, 0), cA + kstep, voffA); PG8_STAGE(PG8_SB(1, 1), cB + hstep + kstep, voffB);
        PG8_WAIT_V(6); PG8_BAR;
    } else {
        PG8_STAGE(PG8_SB(0, 0), cB, voffB); PG8_STAGE(PG8_SA(0, 0), cA, voffA); PG8_STAGE(PG8_SB(0, 1), cB + hstep, voffB); PG8_STAGE(PG8_SA(0, 1), cA + hstep, voffA);
        if (wr == 1) PG8_BAR;
        PG8_WAIT_V(4); PG8_BAR;
        PG8_STAGE(PG8_SB(1, 0), cB + kstep, voffB); PG8_STAGE(PG8_SA(1, 0), cA + kstep, voffA); PG8_STAGE(PG8_SB(1, 1), cB + hstep + kstep, voffB);
        PG8_WAIT_V(6); PG8_BAR;
    }
    for (;;) {
        const bool has_next = S.next(ui + 1, nxt);
        const char* nA = has_next ? PG8_APTR(nxt.pm) : cA; const char* nB = has_next ? (const char*)g.Bt + (size_t)nxt.pn * tstep : cB;
        for (int t = 0; t < nt; t += 2) {
            const bool last = (t == nt - 2);
            const char* a1 = cA + (size_t)(t + 1) * kstep;
            const char* a2 = last ? nA : cA + (size_t)(t + 2) * kstep; const char* b2 = last ? nB : cB + (size_t)(t + 2) * kstep;
            const char* a3 = a2 + kstep; const char* b3 = b2 + kstep;
            if constexpr (SP2) {
            PG8_LDB(B0, 0, 0); PG8_LDB(B1, 0, 1); PG8_SCHED; PG8_LDA(At, 0, 0); PG8_STAGE(PG8_SA(1, 1), a1 + hstep, voffA);
            PG8_WAIT_V(8); PG8_WAIT_L(0); PG8_BAR; PG8_MMA(0, 0, At, B0); PG8_MMA(0, 1, At, B1); PG8_BAR; PG8_SCHED;
            PG8_LDA(At, 0, 1); PG8_STAGE(PG8_SB(0, 0), b2, voffB); PG8_STAGE(PG8_SB(0, 1), b2 + hstep, voffB); PG8_STAGE(PG8_SA(0, 0), a2, voffA);
            PG8_WAIT_V(8); PG8_WAIT_L(0); PG8_BAR; PG8_MMA(1, 0, At, B0); PG8_MMA(1, 1, At, B1); PG8_BAR; PG8_SCHED;
            PG8_LDB(B0, 1, 0); PG8_LDB(B1, 1, 1); PG8_SCHED; PG8_LDA(At, 1, 0); PG8_STAGE(PG8_SA(0, 1), a2 + hstep, voffA);
            PG8_WAIT_V(8); PG8_WAIT_L(0); PG8_BAR; PG8_MMA(0, 0, At, B0); PG8_MMA(0, 1, At, B1); PG8_BAR; PG8_SCHED;
            PG8_LDA(At, 1, 1); PG8_STAGE(PG8_SB(1, 0), b3, voffB); PG8_STAGE(PG8_SB(1, 1), b3 + hstep, voffB); PG8_STAGE(PG8_SA(1, 0), a3, voffA);
            PG8_WAIT_V(8); PG8_WAIT_L(0); PG8_BAR; PG8_MMA(1, 0, At, B0); PG8_MMA(1, 1, At, B1); PG8_BAR; PG8_SCHED;
            } else {
            PG8_LDB(B0, 0, 0); PG8_SCHED; PG8_LDA(At, 0, 0); PG8_STAGE(PG8_SA(1, 1), a1 + hstep, voffA);
            PG8_WAIT_L(8); PG8_BAR; PG8_WAIT_L(0); PG8_MMA(0, 0, At, B0); PG8_BAR; PG8_SCHED;
            PG8_LDB(B1, 0, 1); PG8_STAGE(PG8_SB(0, 0), b2, voffB);
            PG8_BAR; PG8_WAIT_L(0); PG8_MMA(0, 1, At, B1); PG8_BAR;
            PG8_LDA(At, 0, 1); PG8_STAGE(PG8_SA(0, 0), a2, voffA);
            PG8_BAR; PG8_WAIT_L(0); PG8_MMA(1, 0, At, B0); PG8_BAR; PG8_SCHED;
            PG8_STAGE(PG8_SB(0, 1), b2 + hstep, voffB);
            PG8_WAIT_V(6); PG8_BAR; PG8_MMA(1, 1, At, B1); PG8_BAR;
            PG8_LDB(B0, 1, 0); PG8_SCHED; PG8_LDA(At, 1, 0); PG8_STAGE(PG8_SA(0, 1), a2 + hstep, voffA);
            PG8_WAIT_L(8); PG8_BAR; PG8_WAIT_L(0); PG8_MMA(0, 0, At, B0); PG8_BAR; PG8_SCHED;
            PG8_LDB(B1, 1, 1); PG8_STAGE(PG8_SB(1, 0), b3, voffB);
            PG8_BAR; PG8_WAIT_L(0); PG8_MMA(0, 1, At, B1); PG8_BAR;
            PG8_LDA(At, 1, 1); PG8_STAGE(PG8_SA(1, 0), a3, voffA);
            PG8_BAR; PG8_WAIT_L(0); PG8_MMA(1, 0, At, B0); PG8_BAR; PG8_SCHED;
            PG8_STAGE(PG8_SB(1, 1), b3 + hstep, voffB);
            PG8_WAIT_V(6); PG8_BAR; PG8_MMA(1, 1, At, B1); PG8_BAR;
            }
        }
        if constexpr (ALIGN_EPI) { if (wr == 0) PG8_BAR; }
        E(acc, cur, wr, wc, fr, fq);
        if (!has_next) break;
#pragma unroll
        for (int a = 0; a < 2; ++a)
#pragma unroll
            for (int b = 0; b < 2; ++b)
#pragma unroll
                for (int m = 0; m < 4; ++m)
#pragma unroll
                    for (int n = 0; n < 2; ++n) acc[a][b][m][n] = (f32x4){0.f, 0.f, 0.f, 0.f};
        cur = nxt; cA = nA; cB = nB; ++ui;
        if constexpr (ALIGN_EPI) { if (wr == 1) PG8_BAR; }
    }
    PG8_WAIT_V(0);
    if constexpr (!ALIGN_EPI) { if (wr == 0) PG8_BAR; }
    PG8_BAR;
#undef PG8_APTR
#undef PG8_SA
#undef PG8_SB
#undef PG8_STAGE
#undef PG8_LDA
#undef PG8_LDB
#undef PG8_MMA
#undef PG8_WAIT_V
#undef PG8_WAIT_L
#undef PG8_BAR
#undef PG8_SCHED
}
}

__device__ void phase_p0(const Args& a, LAS unsigned char* lds) {
    const int tid = ltid();
    float* mod = (float*)(a.ws + WS_MOD);
    for (int it = lbid(); it < 192; it += gridDim.x) {
        LAS float* sS = (LAS float*)lds; LAS float* red = sS + 9 * 1024;
        for (int e = tid; e < 9 * 1024; e += NT) { const int i = e >> 10, k = e & 1023; const float v = (i < 8) ? a.c[i * 1024 + k] : a.c_ctx[k]; sS[e] = silu(v); }
        __syncthreads();
        const int col = tid & 31, ks = tid >> 5, j = it * 32 + col;
        float acc[9];
#pragma unroll
        for (int i = 0; i < 9; ++i) acc[i] = 0.f;
#pragma unroll 1
        for (int k8 = 0; k8 < 64; k8 += 16) { float w[16];
#pragma unroll
            for (int kk = 0; kk < 16; ++kk) w[kk] = a.w_mod[(size_t)(ks * 64 + k8 + kk) * 6144 + j];
#pragma unroll
            for (int kk = 0; kk < 16; ++kk) { const int k = ks * 64 + k8 + kk;
#pragma unroll
                for (int i = 0; i < 9; ++i) acc[i] += sS[i * 1024 + k] * w[kk]; } }
#pragma unroll
        for (int i = 0; i < 9; ++i) red[(ks * 9 + i) * 32 + col] = acc[i];
        __syncthreads();
        if (tid < 288) { const int i = tid >> 5, cc = tid & 31; float s = 0.f; for (int q = 0; q < 16; ++q) s += red[(q * 9 + i) * 32 + cc]; mod[i * 6144 + it * 32 + cc] = s + a.b_mod[it * 32 + cc]; }
        __syncthreads();
    }
    LAS float* tile = (LAS float*)lds;
    auto decode = [&](int tt, const float*& src, bf16_t*& dst, int& K, int& Ns, int& kt, int& ntl, int& scol) {
        if (tt < 1152) { src = a.w_in; dst = (bf16_t*)(a.ws + WS_WIN); K = 1024; Ns = 4624; kt = tt & 15; ntl = tt >> 4; scol = ntl * 64; if (scol >= 2048) scol += 16; }
        else if (tt < 1408) { const int u = tt - 1152; src = a.w_out; dst = (bf16_t*)(a.ws + WS_WOUT); K = 1024; Ns = 1024; kt = u & 15; ntl = u >> 4; scol = ntl * 64; }
        else if (tt < 2816) { const int u = tt - 1408; src = a.w_up; dst = (bf16_t*)(a.ws + WS_WUP); K = 1024; Ns = 5632; kt = u & 15; ntl = u >> 4; scol = ntl * 64; }
        else { const int u = tt - 2816; src = a.w_down; dst = (bf16_t*)(a.ws + WS_WDN); K = 2816; Ns = 1024; kt = u % 44; ntl = u / 44; scol = ntl * 64; } };
    const int tkk = tid >> 4, tn4 = (tid & 15) * 4;
    auto ldtile = [&](int tt, f32x4& v0, f32x4& v1) { const float* src; bf16_t* dst; int K, Ns, kt, ntl, scol; decode(tt, src, dst, K, Ns, kt, ntl, scol);
        v0 = *(const f32x4*)(src + (size_t)(kt * 64 + tkk) * Ns + scol + tn4); v1 = *(const f32x4*)(src + (size_t)(kt * 64 + tkk + 32) * Ns + scol + tn4); };
    f32x4 c0, c1, n0, n1; int tt = lbid();
    if (tt < 3520) ldtile(tt, c0, c1);
    for (; tt < 3520; tt += gridDim.x) {
        const int tnx = tt + gridDim.x; if (tnx < 3520) ldtile(tnx, n0, n1);
        const float* src; bf16_t* dst; int K, Ns, kt, ntl, scol; decode(tt, src, dst, K, Ns, kt, ntl, scol);
        tile[tkk * 65 + tn4] = c0[0]; tile[tkk * 65 + tn4 + 1] = c0[1]; tile[tkk * 65 + tn4 + 2] = c0[2]; tile[tkk * 65 + tn4 + 3] = c0[3];
        tile[(tkk + 32) * 65 + tn4] = c1[0]; tile[(tkk + 32) * 65 + tn4 + 1] = c1[1]; tile[(tkk + 32) * 65 + tn4 + 2] = c1[2]; tile[(tkk + 32) * 65 + tn4 + 3] = c1[3];
        __syncthreads();
        { const int n = tid >> 3, k8 = (tid & 7) * 8; u32x4 w;
          w.x = pack2(tile[(k8 + 0) * 65 + n], tile[(k8 + 1) * 65 + n]); w.y = pack2(tile[(k8 + 2) * 65 + n], tile[(k8 + 3) * 65 + n]);
          w.z = pack2(tile[(k8 + 4) * 65 + n], tile[(k8 + 5) * 65 + n]); w.w = pack2(tile[(k8 + 6) * 65 + n], tile[(k8 + 7) * 65 + n]);
          *(u32x4*)(dst + (size_t)(ntl * 64 + n) * K + kt * 64 + k8) = w; }
        __syncthreads();
        c0 = n0; c1 = n1;
    }
}

__device__ void phase_p1(const Args& a, LAS unsigned char* lds) {
    const int tid = ltid(), lane = tid & 63, wave = tid >> 6;
    LAS float* wgT = (LAS float*)lds;
    for (int e = tid; e < 16384; e += NT) { const int k = e >> 4, j = e & 15; wgT[j * 1024 + k] = a.w_in[(size_t)k * 4624 + 2048 + j]; }
    __syncthreads();
    const float* mod = (const float*)(a.ws + WS_MOD);
    bf16_t* A1 = (bf16_t*)(a.ws + WS_R1);
    float* gates = (float*)(a.ws + WS_GATES);
    const int rstep = gridDim.x * 8;
    for (int row0 = lbid() * 8 + wave; row0 < NROWS; row0 += 2 * rstep) {
        const int row1r = row0 + rstep; const bool has1 = row1r < NROWS; const int row1 = has1 ? row1r : row0;
        const float* src0 = row0 < NLAT ? a.x + (size_t)row0 * 1024 : a.ctx + (size_t)(row0 - NLAT) * 1024;
        const float* src1 = row1 < NLAT ? a.x + (size_t)row1 * 1024 : a.ctx + (size_t)(row1 - NLAT) * 1024;
        const float* mb0 = mod + (row0 < NLAT ? (row0 >> 12) : 8) * 6144; const float* mb1 = mod + (row1 < NLAT ? (row1 >> 12) : 8) * 6144;
        float ss0 = 0.f, ss1 = 0.f;
#pragma unroll
        for (int i = 0; i < 8; ++i) { const f32x2 x0 = *(const f32x2*)(src0 + i * 128 + lane * 2), x1 = *(const f32x2*)(src1 + i * 128 + lane * 2); ss0 += x0.x * x0.x + x0.y * x0.y; ss1 += x1.x * x1.x + x1.y * x1.y; }
        ss0 = wsum(ss0); ss1 = wsum(ss1);
        const float rs0 = rsqrtf(ss0 * (1.f / 1024.f) + 1e-6f), rs1 = rsqrtf(ss1 * (1.f / 1024.f) + 1e-6f);
        float g0[16], g1[16];
#pragma unroll
        for (int j = 0; j < 16; ++j) { g0[j] = 0.f; g1[j] = 0.f; }
        f32x2 xv0 = *(const f32x2*)(src0 + lane * 2), xv1 = *(const f32x2*)(src1 + lane * 2), nw = *(const f32x2*)(a.norm1_w + lane * 2);
        f32x2 sh0 = *(const f32x2*)(mb0 + lane * 2), sc0 = *(const f32x2*)(mb0 + 1024 + lane * 2), sh1 = *(const f32x2*)(mb1 + lane * 2), sc1 = *(const f32x2*)(mb1 + 1024 + lane * 2);
#pragma unroll 1
        for (int i = 0; i < 8; ++i) { const int k = i * 128 + lane * 2; const int kn = ((i + 1) & 7) * 128 + lane * 2;
            const f32x2 xn0 = *(const f32x2*)(src0 + kn), xn1 = *(const f32x2*)(src1 + kn), nwn = *(const f32x2*)(a.norm1_w + kn);
            const f32x2 shn0 = *(const f32x2*)(mb0 + kn), scn0 = *(const f32x2*)(mb0 + 1024 + kn), shn1 = *(const f32x2*)(mb1 + kn), scn1 = *(const f32x2*)(mb1 + 1024 + kn);
            const float a00 = xv0.x * rs0 * nw.x * (1.f + sc0.x) + sh0.x, a01 = xv0.y * rs0 * nw.y * (1.f + sc0.y) + sh0.y;
            const float a10 = xv1.x * rs1 * nw.x * (1.f + sc1.x) + sh1.x, a11 = xv1.y * rs1 * nw.y * (1.f + sc1.y) + sh1.y;
            *(unsigned*)(A1 + (size_t)row0 * 1024 + k) = pack2(a00, a01);
            if (has1) *(unsigned*)(A1 + (size_t)row1 * 1024 + k) = pack2(a10, a11);
#pragma unroll
            for (int j = 0; j < 16; ++j) { const f32x2 w = *(const LAS f32x2*)(wgT + j * 1024 + k); g0[j] += a00 * w.x + a01 * w.y; g1[j] += a10 * w.x + a11 * w.y; }
            xv0 = xn0; xv1 = xn1; nw = nwn; sh0 = shn0; sc0 = scn0; sh1 = shn1; sc1 = scn1; }
        float out0 = 0.f, out1 = 0.f;
#pragma unroll
        for (int j = 0; j < 16; ++j) { const float s0 = wsum(g0[j]), s1 = wsum(g1[j]); if (lane == j) { out0 = s0; out1 = s1; } }
        if (lane < 16) { gates[(size_t)row0 * 16 + lane] = out0 + a.gate_b[lane]; if (has1) gates[(size_t)row1 * 16 + lane] = out1 + a.gate_b[lane]; }
    }
}

__device__ void phase_n2(const Args& a) {
    const int tid = ltid(), lane = tid & 63, wave = tid >> 6;
    const float* mod = (const float*)(a.ws + WS_MOD);
    bf16_t* A2 = (bf16_t*)(a.ws + WS_A2);
    const int rstep = gridDim.x * 8;
    for (int row0 = lbid() * 8 + wave; row0 < NLAT; row0 += 2 * rstep) {
        f32x4 v[2][4]; float ss[2] = {0.f, 0.f};
#pragma unroll
        for (int q = 0; q < 2; ++q) { const int row = row0 + q * rstep; if (row < NLAT) { const float* src = a.out + (size_t)row * 1024;
#pragma unroll
            for (int i = 0; i < 4; ++i) v[q][i] = *(const f32x4*)(src + i * 256 + lane * 4); } }
#pragma unroll
        for (int q = 0; q < 2; ++q) { const int row = row0 + q * rstep; if (row < NLAT) {
#pragma unroll
            for (int i = 0; i < 4; ++i) ss[q] += v[q][i][0] * v[q][i][0] + v[q][i][1] * v[q][i][1] + v[q][i][2] * v[q][i][2] + v[q][i][3] * v[q][i][3]; } }
        ss[0] = wsum(ss[0]); ss[1] = wsum(ss[1]);
#pragma unroll
        for (int q = 0; q < 2; ++q) { const int row = row0 + q * rstep; if (row < NLAT) { const float rs = rsqrtf(ss[q] * (1.f / 1024.f) + 1e-6f); const float* mb = mod + (row >> 12) * 6144;
#pragma unroll
            for (int i = 0; i < 4; ++i) { const int k = i * 256 + lane * 4;
                const f32x4 nw = *(const f32x4*)(a.norm2_w + k), sh = *(const f32x4*)(mb + 3072 + k), sc = *(const f32x4*)(mb + 4096 + k);
                u32x2 w; w.x = pack2(v[q][i][0] * rs * nw[0] * (1.f + sc[0]) + sh[0], v[q][i][1] * rs * nw[1] * (1.f + sc[1]) + sh[1]);
                w.y = pack2(v[q][i][2] * rs * nw[2] * (1.f + sc[2]) + sh[2], v[q][i][3] * rs * nw[3] * (1.f + sc[3]) + sh[3]);
                *(u32x2*)(A2 + (size_t)row * 1024 + k) = w; } } }
    }
}
__device__ void phase_fn(const Args& a) {
    const int tid = ltid(), lane = tid & 63, wave = tid >> 6;
    const int rstep = gridDim.x * 8;
    f32x4 nw[4];
#pragma unroll
    for (int i = 0; i < 4; ++i) nw[i] = *(const f32x4*)(a.final_w + i * 256 + lane * 4);
    for (int row0 = lbid() * 8 + wave; row0 < NLAT; row0 += 2 * rstep) {
        f32x4 v[2][4]; float ss[2] = {0.f, 0.f};
#pragma unroll
        for (int q = 0; q < 2; ++q) { const int row = row0 + q * rstep; if (row < NLAT) { const float* src = a.out + (size_t)row * 1024;
#pragma unroll
            for (int i = 0; i < 4; ++i) v[q][i] = *(const f32x4*)(src + i * 256 + lane * 4); } }
#pragma unroll
        for (int q = 0; q < 2; ++q) { const int row = row0 + q * rstep; if (row < NLAT) {
#pragma unroll
            for (int i = 0; i < 4; ++i) ss[q] += v[q][i][0] * v[q][i][0] + v[q][i][1] * v[q][i][1] + v[q][i][2] * v[q][i][2] + v[q][i][3] * v[q][i][3]; } }
        ss[0] = wsum(ss[0]); ss[1] = wsum(ss[1]);
#pragma unroll
        for (int q = 0; q < 2; ++q) { const int row = row0 + q * rstep; if (row < NLAT) { const float rs = rsqrtf(ss[q] * (1.f / 1024.f) + 1e-6f); float* dst = a.out + (size_t)row * 1024;
#pragma unroll
            for (int i = 0; i < 4; ++i) *(f32x4*)(dst + i * 256 + lane * 4) = v[q][i] * rs * nw[i]; } }
    }
}

__device__ void phase_mc(const Args& a) {
    const int tid = ltid(), cgi = tid & 127, seg = tid >> 7, c0 = cgi * 8;
    const bf16_t* P = (const bf16_t*)(a.ws + WS_P); bf16_t* QK = (bf16_t*)(a.ws + WS_R1);
    float w[9][8];
#pragma unroll
    for (int t = 0; t < 9; ++t) { const f32x4 w0 = *(const f32x4*)(a.ml_conv_w + t * 1024 + c0), w1 = *(const f32x4*)(a.ml_conv_w + t * 1024 + c0 + 4);
        w[t][0] = w0[0]; w[t][1] = w0[1]; w[t][2] = w0[2]; w[t][3] = w0[3]; w[t][4] = w1[0]; w[t][5] = w1[1]; w[t][6] = w1[2]; w[t][7] = w1[3]; }
    const float qs = (c0 < 512) ? 0.08838834764831845f : 1.f;
    for (int it = lbid(); it < 640; it += gridDim.x) {
        int rowbase, W, H, y0, nrows, xb;
        if (it < 512) { const int b = it >> 6; rowbase = b * 4096; W = 64; H = 64; y0 = ((it >> 2) & 15) * 4; nrows = 4; xb = (it & 3) * 16; }
        else { const int ci = it - 512; rowbase = NLAT + (ci >> 4) * 256; W = 256; H = 1; y0 = 0; nrows = 1; xb = (ci & 15) * 16; }
        const int x0 = xb + seg * 4;
        u32x4 r[3][6];
        auto ldrow = [&](int y, u32x4 (&d)[6]) {
            const bool vy = (y >= 0 && y < H);
#pragma unroll
            for (int j = 0; j < 6; ++j) { const int xx = x0 - 1 + j;
                d[j] = (vy && xx >= 0 && xx < W) ? *(const u32x4*)(P + (size_t)(rowbase + y * W + xx) * NPC + c0) : (u32x4){0u, 0u, 0u, 0u}; } };
        ldrow(y0 - 1, r[0]); ldrow(y0, r[1]);
#pragma unroll 1
        for (int ry = 0; ry < nrows; ++ry) { const int y = y0 + ry;
            ldrow(y + 1, r[2]);
#pragma unroll
            for (int xi = 0; xi < 4; ++xi) {
                float acc[8];
#pragma unroll
                for (int e = 0; e < 8; ++e) acc[e] = 0.f;
#pragma unroll
                for (int dy = 0; dy < 3; ++dy)
#pragma unroll
                    for (int dx = 0; dx < 3; ++dx) { const u32x4 d = r[dy][xi + dx]; const int t = dy * 3 + dx;
                        acc[0] += lo_f(d.x) * w[t][0]; acc[1] += hi_f(d.x) * w[t][1]; acc[2] += lo_f(d.y) * w[t][2]; acc[3] += hi_f(d.y) * w[t][3];
                        acc[4] += lo_f(d.z) * w[t][4]; acc[5] += hi_f(d.z) * w[t][5]; acc[6] += lo_f(d.w) * w[t][6]; acc[7] += hi_f(d.w) * w[t][7]; }
                u32x4 o; o.x = pack2(silu(acc[0]) * qs, silu(acc[1]) * qs); o.y = pack2(silu(acc[2]) * qs, silu(acc[3]) * qs);
                o.z = pack2(silu(acc[4]) * qs, silu(acc[5]) * qs); o.w = pack2(silu(acc[6]) * qs, silu(acc[7]) * qs);
                *(u32x4*)(QK + (size_t)(rowbase + y * W + x0 + xi) * 1024 + c0) = o; }
#pragma unroll
            for (int j = 0; j < 6; ++j) { r[0][j] = r[1][j]; r[1][j] = r[2][j]; }
        }
    }
}

__device__ void phase_cv(const Args& a, int b_lo, bf16_t* ACT) {
    const int tid = ltid(), cgl = tid & 31, seg = tid >> 5;
    const bf16_t* U = (const bf16_t*)(a.ws + WS_U);
    for (int it = lbid(); it < 1408; it += gridDim.x) {
        const int cb = it % 22, band = (it / 22) & 15, bb = it / 352;
        const int c = cb * 128 + cgl * 4, y0 = band * 4, x0 = seg * 4;
        float wa[9][4], wb[9][4];
#pragma unroll
        for (int t = 0; t < 9; ++t) { const f32x4 w0 = *(const f32x4*)(a.ffn_conv_w + t * 5632 + c), w1 = *(const f32x4*)(a.ffn_conv_w + t * 5632 + 2816 + c);
            wa[t][0] = w0[0]; wa[t][1] = w0[1]; wa[t][2] = w0[2]; wa[t][3] = w0[3]; wb[t][0] = w1[0]; wb[t][1] = w1[1]; wb[t][2] = w1[2]; wb[t][3] = w1[3]; }
        const size_t rowb = (size_t)(b_lo + bb) * 4096;
        u32x2 ra[3][6], rbv[3][6];
        auto ldrow = [&](int y, u32x2 (&da)[6], u32x2 (&db)[6]) {
            const bool vy = (y >= 0 && y < 64);
#pragma unroll
            for (int j = 0; j < 6; ++j) { const int xx = x0 - 1 + j;
                if (vy && xx >= 0 && xx < 64) { const bf16_t* p = U + (rowb + y * 64 + xx) * 5632 + c; da[j] = *(const u32x2*)p; db[j] = *(const u32x2*)(p + 2816); }
                else { da[j] = (u32x2){0u, 0u}; db[j] = (u32x2){0u, 0u}; } } };
        ldrow(y0 - 1, ra[0], rbv[0]); ldrow(y0, ra[1], rbv[1]);
#pragma unroll
        for (int ry = 0; ry < 4; ++ry) { const int y = y0 + ry;
            ldrow(y + 1, ra[2], rbv[2]);
#pragma unroll
            for (int xi = 0; xi < 4; ++xi) {
                float aa[4] = {0.f, 0.f, 0.f, 0.f}, ab[4] = {0.f, 0.f, 0.f, 0.f};
#pragma unroll
                for (int dy = 0; dy < 3; ++dy)
#pragma unroll
                    for (int dx = 0; dx < 3; ++dx) { const int t = dy * 3 + dx; const u32x2 d = ra[dy][xi + dx], e = rbv[dy][xi + dx];
                        aa[0] += lo_f(d.x) * wa[t][0]; aa[1] += hi_f(d.x) * wa[t][1]; aa[2] += lo_f(d.y) * wa[t][2]; aa[3] += hi_f(d.y) * wa[t][3];
                        ab[0] += lo_f(e.x) * wb[t][0]; ab[1] += hi_f(e.x) * wb[t][1]; ab[2] += lo_f(e.y) * wb[t][2]; ab[3] += hi_f(e.y) * wb[t][3]; }
                u32x2 o; o.x = pack2(silu(aa[0]) * ab[0], silu(aa[1]) * ab[1]); o.y = pack2(silu(aa[2]) * ab[2], silu(aa[3]) * ab[3]);
                *(u32x2*)(ACT + ((size_t)bb * 4096 + y * 64 + x0 + xi) * 2816 + c) = o; }
#pragma unroll
            for (int j = 0; j < 6; ++j) { ra[0][j] = ra[1][j]; ra[1][j] = ra[2][j]; rbv[0][j] = rbv[1][j]; rbv[1][j] = rbv[2][j]; }
        }
    }
}

__device__ __forceinline__ void ml_scan(const LAS float* lf, const LAS float* ig, bool rev, int lane, float (&b)[4], float (&c)[4], float (&gm)[4], float& Btot, float& cmax) {
    float l[4], s = 0.f;
#pragma unroll
    for (int i = 0; i < 4; ++i) { const int p = 4 * lane + i, t = rev ? 255 - p : p; l[i] = lf[t]; s += l[i]; }
    const float incl = wscan_add(s, lane); float run = incl - s; Btot = __shfl(incl, 63);
    float cm = -INFINITY;
#pragma unroll
    for (int i = 0; i < 4; ++i) { const int p = 4 * lane + i, t = rev ? 255 - p : p; run += l[i]; b[i] = run; c[i] = ig[t] - run; cm = fmaxf(cm, c[i]); gm[i] = cm; }
    const float im = wscan_max(cm, lane); float ex = __shfl_up(im, 1); if (lane == 0) ex = -INFINITY;
#pragma unroll
    for (int i = 0; i < 4; ++i) gm[i] = fmaxf(gm[i], ex);
    cmax = __shfl(im, 63);
}

__device__ __forceinline__ void m1_matmul_store(const LAS unsigned char* vT, const LAS unsigned char* kT, bf16_t* dst, int wave, int lane) {
    const int r = lane & 15, kg = lane >> 4;
    f32x4 acc[8];
#pragma unroll
    for (int n = 0; n < 8; ++n) acc[n] = (f32x4){0.f, 0.f, 0.f, 0.f};
    const LAS unsigned char* pa = vT + (wave * 16 + r) * 528 + kg * 16;
    const LAS unsigned char* pb = kT + r * 528 + kg * 16;
#pragma unroll 2
    for (int ks = 0; ks < 8; ++ks) { const bf16x8 av = *(const LAS bf16x8*)(pa + ks * 64);
#pragma unroll
        for (int n = 0; n < 8; ++n) { const bf16x8 bv = *(const LAS bf16x8*)(pb + n * 16 * 528 + ks * 64); acc[n] = MFMA16(av, bv, acc[n]); } }
#pragma unroll
    for (int n = 0; n < 8; ++n)
#pragma unroll
        for (int j = 0; j < 4; ++j) dst[(wave * 16 + kg * 4 + j) * 128 + n * 16 + r] = f2bf(acc[n][j]);
}

__device__ __forceinline__ void load_vT256(const bf16_t* src, int ld, LAS unsigned char* vT, int tid) {
    const int s = tid & 255, half = tid >> 8;
    const bf16_t* p = src + (size_t)s * ld + half * 64;
#pragma unroll
    for (int q = 0; q < 8; ++q) { const u32x4 d = *(const u32x4*)(p + q * 8); const int cb = half * 64 + q * 8;
        LAS bf16_t* o = (LAS bf16_t*)vT + cb * 264 + s;
        o[0] = (bf16_t)(d.x & 0xffff); o[264] = (bf16_t)(d.x >> 16); o[2 * 264] = (bf16_t)(d.y & 0xffff); o[3 * 264] = (bf16_t)(d.y >> 16);
        o[4 * 264] = (bf16_t)(d.z & 0xffff); o[5 * 264] = (bf16_t)(d.z >> 16); o[6 * 264] = (bf16_t)(d.w & 0xffff); o[7 * 264] = (bf16_t)(d.w >> 16); }
}

constexpr int M1_VT = 0, M1_KT = 67584, M1_MISC = 135168;
__device__ void m1_hg_item(const Args& a, LAS unsigned char* lds, int rowbase, int h, int seqF, int slotF, int slotB);

__device__ void phase_m1(const Args& a, LAS unsigned char* lds) {
    const int tid = ltid(), lane = tid & 63, wave = tid >> 6;
    const bf16_t* P = (const bf16_t*)(a.ws + WS_P); const bf16_t* QK = (const bf16_t*)(a.ws + WS_R1);
    const float* gates = (const float*)(a.ws + WS_GATES);
    bf16_t* mlst = (bf16_t*)a.out; bf16_t* hgst = (bf16_t*)a.out + (size_t)1024 * 16384;
    float* ml_n = (float*)(a.ws + WS_SMALL + SM_MLN); float* hg_B = (float*)(a.ws + WS_SMALL + SM_HGB);
    float* ml_mloc = (float*)(a.ws + WS_SMALL + SM_MLOC); float* ml_B = (float*)(a.ws + WS_SMALL + SM_MLB);
    LAS unsigned char* vT = lds + M1_VT; LAS unsigned char* kT = lds + M1_KT;
    LAS float* misc = (LAS float*)(lds + M1_MISC);
    LAS float *lfF = misc, *igF = misc + 256, *lfB = misc + 512, *igB = misc + 768, *wF = misc + 1024, *wB = misc + 1280, *scal = misc + 1536, *nred = misc + 1552;
    const int nblk = gridDim.x, bidx = lbid(); const int nheavy3 = (nblk == 256) ? 64 : 0;
    for (int pass = 0; pass < 2; ++pass) {
      const bool isml = pass == 1; const int qstart = isml ? bidx - nheavy3 : bidx, qstride = isml ? nblk - nheavy3 : nblk, qend = isml ? 544 : 1088;
      if (qstart < 0) continue;
      for (int qq = qstart; qq < qend; qq += qstride) {
        const int q = isml ? qq : (qq >> 1); const int hdir = qq & 1;
        const int b = q / 68, h = (q / 17) & 3, sc = q % 17;
        const int rowbase = sc == 0 ? NLAT + b * 256 : b * 4096 + (sc - 1) * 256;
        int slotF = sc <= 15 ? sc : -1, slotB = sc == 0 ? 0 : (sc >= 2 ? 17 - sc : -1);
        if (!isml) { if (hdir) slotF = -1; else slotB = -1; if (slotF < 0 && slotB < 0) continue; }
        const int seqF = (b * 4 + h) * 2, seqB = seqF + 1;
        __syncthreads();
        if (isml) {
            if (tid < 256) { const float* g = gates + (size_t)(rowbase + tid) * 16; igF[tid] = g[h]; lfF[tid] = logsig(g[4 + h]); igB[tid] = g[8 + h]; lfB[tid] = logsig(g[12 + h]); }
            load_vT256(P + (size_t)rowbase * NPC + 1024 + h * 128, NPC, vT, tid);
            __syncthreads();
            if (wave < 2) { float bb[4], cc[4], gm[4], Bt, cmx; const bool rev = wave == 1;
                ml_scan(rev ? lfB : lfF, rev ? igB : igF, rev, lane, bb, cc, gm, Bt, cmx);
                LAS float* wd = rev ? wB : wF;
#pragma unroll
                for (int i = 0; i < 4; ++i) { const int p = 4 * lane + i, t = rev ? 255 - p : p; wd[t] = __expf(cc[i] - cmx); }
                if (lane == 0) { scal[wave * 2] = Bt + cmx; scal[wave * 2 + 1] = Bt; } }
            const int s = tid & 255, half = tid >> 8;
            u32x4 kr[8];
            { const bf16_t* p = QK + (size_t)(rowbase + s) * 1024 + 512 + h * 128 + half * 64;
#pragma unroll
              for (int qq = 0; qq < 8; ++qq) kr[qq] = *(const u32x4*)(p + qq * 8); }
            __syncthreads();
#pragma unroll
            for (int dir = 0; dir < 2; ++dir) {
                const int slot = dir ? slotB : slotF; const int seq = dir ? seqB : seqF;
                if (slot >= 0) {
                    const float wv = dir ? wB[s] : wF[s];
#pragma unroll
                    for (int qq = 0; qq < 8; ++qq) { const u32x4 d = kr[qq]; LAS bf16_t* o = (LAS bf16_t*)kT + (half * 64 + qq * 8) * 264 + s;
                        o[0] = f2bf(lo_f(d.x) * wv); o[264] = f2bf(hi_f(d.x) * wv); o[2 * 264] = f2bf(lo_f(d.y) * wv); o[3 * 264] = f2bf(hi_f(d.y) * wv);
                        o[4 * 264] = f2bf(lo_f(d.z) * wv); o[5 * 264] = f2bf(hi_f(d.z) * wv); o[6 * 264] = f2bf(lo_f(d.w) * wv); o[7 * 264] = f2bf(hi_f(d.w) * wv); }
                    __syncthreads();
                    m1_matmul_store(vT, kT, mlst + (size_t)(seq * 16 + slot) * 16384, wave, lane);
                    { const int dk = tid & 127, part = tid >> 7; float sm = 0.f; const LAS bf16_t* kp = (const LAS bf16_t*)kT + dk * 264 + part * 64;
                      for (int e = 0; e < 64; ++e) sm += bf2f(kp[e]);
                      nred[part * 128 + dk] = sm; }
                    __syncthreads();
                    if (tid < 128) ml_n[(size_t)(seq * 16 + slot) * 128 + tid] = nred[tid] + nred[128 + tid] + nred[256 + tid] + nred[384 + tid];
                    if (tid == 0) { ml_mloc[seq * 16 + slot] = scal[dir * 2]; ml_B[seq * 16 + slot] = scal[dir * 2 + 1]; }
                }
            }
        } else {
            m1_hg_item(a, lds, rowbase, h, seqF, slotF, slotB);
        }
    }
  }
}

__device__ void phase_m2(const Args& a) {
    bf16_t* mlst = (bf16_t*)a.out; bf16_t* hgst = (bf16_t*)a.out + (size_t)1024 * 16384;
    float* ml_n = (float*)(a.ws + WS_SMALL + SM_MLN); const float* hg_B = (const float*)(a.ws + WS_SMALL + SM_HGB);
    const float* ml_mloc = (const float*)(a.ws + WS_SMALL + SM_MLOC); const float* ml_B = (const float*)(a.ws + WS_SMALL + SM_MLB); float* ml_mpre = (float*)(a.ws + WS_SMALL + SM_MPRE);
    const int gtid = lbid() * NT + ltid(), gn = gridDim.x * NT;
    for (int g = gtid; g < 64 * 2048; g += gn) {
        const int seq = g >> 11, ch = g & 2047;
        bf16_t* base = mlst + (size_t)seq * 16 * 16384 + ch * 8;
        float m = ml_mloc[seq * 16]; float C[8];
        { const u32x4 d = *(const u32x4*)base; C[0] = lo_f(d.x); C[1] = hi_f(d.x); C[2] = lo_f(d.y); C[3] = hi_f(d.y); C[4] = lo_f(d.z); C[5] = hi_f(d.z); C[6] = lo_f(d.w); C[7] = hi_f(d.w); }
        if (ch == 0) ml_mpre[seq * 16] = m;
        u32x4 dnx = *(const u32x4*)(base + (size_t)16384);
        for (int p = 1; p < 16; ++p) { const float ml = ml_mloc[seq * 16 + p], B = ml_B[seq * 16 + p]; const float mn = fmaxf(B + m, ml); const float fa = __expf(B + m - mn), fb = __expf(ml - mn);
            const u32x4 d = dnx; if (p < 15) dnx = *(const u32x4*)(base + (size_t)(p + 1) * 16384);
            C[0] = fa * C[0] + fb * lo_f(d.x); C[1] = fa * C[1] + fb * hi_f(d.x); C[2] = fa * C[2] + fb * lo_f(d.y); C[3] = fa * C[3] + fb * hi_f(d.y);
            C[4] = fa * C[4] + fb * lo_f(d.z); C[5] = fa * C[5] + fb * hi_f(d.z); C[6] = fa * C[6] + fb * lo_f(d.w); C[7] = fa * C[7] + fb * hi_f(d.w);
            u32x4 o; o.x = pack2(C[0], C[1]); o.y = pack2(C[2], C[3]); o.z = pack2(C[4], C[5]); o.w = pack2(C[6], C[7]);
            *(u32x4*)(base + (size_t)p * 16384) = o; m = mn; if (ch == 0) ml_mpre[seq * 16 + p] = m; }
    }
    for (int g = gtid; g < 64 * 128; g += gn) {
        const int seq = g >> 7, dk = g & 127; float* base = ml_n + (size_t)seq * 16 * 128 + dk;
        float m = ml_mloc[seq * 16], n = base[0];
        for (int p = 1; p < 16; ++p) { const float ml = ml_mloc[seq * 16 + p], B = ml_B[seq * 16 + p]; const float mn = fmaxf(B + m, ml);
            n = __expf(B + m - mn) * n + __expf(ml - mn) * base[p * 128]; base[p * 128] = n; m = mn; }
    }
    for (int g = gtid; g < 64 * 2048; g += gn) {
        const int seq = g >> 11, ch = g & 2047, dk0 = (ch * 8) & 127;
        bf16_t* base = hgst + (size_t)seq * 16 * 16384 + ch * 8;
        float C[8];
        { const u32x4 d = *(const u32x4*)base; C[0] = lo_f(d.x); C[1] = hi_f(d.x); C[2] = lo_f(d.y); C[3] = hi_f(d.y); C[4] = lo_f(d.z); C[5] = hi_f(d.z); C[6] = lo_f(d.w); C[7] = hi_f(d.w); }
        u32x4 dnx = *(const u32x4*)(base + (size_t)16384);
        for (int p = 1; p < 16; ++p) { const float* bp = hg_B + (size_t)(seq * 16 + p) * 128 + dk0; const f32x4 b0 = *(const f32x4*)bp, b1 = *(const f32x4*)(bp + 4);
            const u32x4 d = dnx; if (p < 15) dnx = *(const u32x4*)(base + (size_t)(p + 1) * 16384);
            C[0] = __expf(b0[0]) * C[0] + lo_f(d.x); C[1] = __expf(b0[1]) * C[1] + hi_f(d.x); C[2] = __expf(b0[2]) * C[2] + lo_f(d.y); C[3] = __expf(b0[3]) * C[3] + hi_f(d.y);
            C[4] = __expf(b1[0]) * C[4] + lo_f(d.z); C[5] = __expf(b1[1]) * C[5] + hi_f(d.z); C[6] = __expf(b1[2]) * C[6] + lo_f(d.w); C[7] = __expf(b1[3]) * C[7] + hi_f(d.w);
            u32x4 o; o.x = pack2(C[0], C[1]); o.y = pack2(C[2], C[3]); o.z = pack2(C[4], C[5]); o.w = pack2(C[6], C[7]);
            *(u32x4*)(base + (size_t)p * 16384) = o; }
    }
}

constexpr int HG_Q1 = 0, HG_K1 = 17408, HG_KST = 34816, HG_VT = 53248, HG_PB = 71680, HG_ST = 80896, HG_MISC = 115712;

struct StageRegs { u32x4 a0, a1, b0, b1, v0, v1; float g0, g1; };
template <int DIR, bool OUT>
__device__ __forceinline__ void hg_fetch(const Args& a, int rb, int h, StageRegs& R) {
    const int tid = ltid(); const bf16_t* P = (const bf16_t*)(a.ws + WS_P);
    const int s = tid >> 3, sg8 = tid & 7; const bf16_t* rp = P + (size_t)(rb + s) * NPC + h * 128 + sg8 * 16;
    R.a0 = *(const u32x4*)(rp + 2560 + DIR * 512); R.a1 = *(const u32x4*)(rp + 2560 + DIR * 512 + 8);
    if (OUT) { R.b0 = *(const u32x4*)(rp + 2048); R.b1 = *(const u32x4*)(rp + 2048 + 8); }
    const int s2 = tid & 63, cp = tid >> 6; const bf16_t* vp = P + (size_t)(rb + s2) * NPC + 3584 + h * 128 + cp * 16;
    R.v0 = *(const u32x4*)vp; R.v1 = *(const u32x4*)(vp + 8);
}
__device__ __forceinline__ void stage_vT64(LAS unsigned char* lds, int tid, const u32x4& d0, const u32x4& d1) {
    const int s2 = tid & 63, cp = tid >> 6;
#pragma unroll
    for (int qq = 0; qq < 2; ++qq) { const u32x4 d = qq ? d1 : d0; LAS bf16_t* o = (LAS bf16_t*)(lds + HG_VT) + (cp * 16 + qq * 8) * 72 + s2;
        o[0] = (bf16_t)(d.x & 0xffff); o[72] = (bf16_t)(d.x >> 16); o[2 * 72] = (bf16_t)(d.y & 0xffff); o[3 * 72] = (bf16_t)(d.y >> 16);
        o[4 * 72] = (bf16_t)(d.z & 0xffff); o[5 * 72] = (bf16_t)(d.z >> 16); o[6 * 72] = (bf16_t)(d.w & 0xffff); o[7 * 72] = (bf16_t)(d.w >> 16); }
}
template <int DIR, bool OUT>
__device__ __forceinline__ void hg_sub(const Args& a, LAS unsigned char* lds, int rbn, int h, float lb, f32x4 (&st)[8], f32x4 (&oacc)[4], float& bLsum, StageRegs& R) {
    int tid = ltid();
    const int lane = tid & 63, wave = tid >> 6, r = lane & 15, kg = lane >> 4;
    LAS float* misc = (LAS float*)(lds + HG_MISC); LAS float* psum = misc; LAS float* eBL = misc + 512;
    { const int s = tid >> 3, sg8 = tid & 7;
      *(LAS u32x4*)(lds + HG_K1 + s * 272 + sg8 * 32) = R.a0; *(LAS u32x4*)(lds + HG_K1 + s * 272 + sg8 * 32 + 16) = R.a1;
      if (OUT) { *(LAS u32x4*)(lds + HG_Q1 + s * 272 + sg8 * 32) = R.b0; *(LAS u32x4*)(lds + HG_Q1 + s * 272 + sg8 * 32 + 16) = R.b1; }
      stage_vT64(lds, tid, R.v0, R.v1);
      if (rbn >= 0) hg_fetch<DIR, OUT>(a, rbn, h, R); }
    __syncthreads();
    { const int c = tid & 127, part = tid >> 7;
      float sm = 0.f; float sgv[16], lfv[16];
#pragma unroll
      for (int i = 0; i < 16; ++i) { const int u = part * 16 + i, t = DIR ? 63 - u : u; const float z = bf2f(((const LAS bf16_t*)(lds + HG_K1))[t * 136 + c]); sgv[i] = sigm(z); lfv[i] = __logf(lb + (1.f - lb) * sgv[i]); sm += lfv[i]; }
      psum[part * 128 + c] = sm;
      __syncthreads();
      const float p0 = psum[c], p1 = psum[128 + c], p2 = psum[256 + c], p3 = psum[384 + c];
      const float ref = p0 + p1, bL = p0 + p1 + p2 + p3;
      float run = part == 0 ? 0.f : (part == 1 ? p0 : (part == 2 ? p0 + p1 : p0 + p1 + p2));
      if (part == 0) eBL[c] = __expf(bL);
      bLsum += bL;
      const float ebr = __expf(bL - ref);
#pragma unroll
      for (int i = 0; i < 16; ++i) { const int u = part * 16 + i, t = DIR ? 63 - u : u;
          run += lfv[i]; const float kk = (1.f - lb) * (1.f - sgv[i]);
          if (OUT) { const float qv = bf2f(((const LAS bf16_t*)(lds + HG_Q1))[t * 136 + c]);
              const float er = __expf(run - ref); const float kr = kk * __builtin_amdgcn_rcpf(er);
              ((LAS bf16_t*)(lds + HG_Q1))[t * 136 + c] = f2bf(qv * er);
              ((LAS bf16_t*)(lds + HG_K1))[t * 136 + c] = f2bf(kr);
              ((LAS bf16_t*)(lds + HG_KST))[c * 72 + t] = f2bf(kr * ebr); }
          else ((LAS bf16_t*)(lds + HG_KST))[c * 72 + t] = f2bf(kk * __expf(bL - run)); }
      if (OUT) {
#pragma unroll
          for (int n = 0; n < 8; ++n) { const int dk = n * 16 + r; const float e = __expf(psum[dk] + psum[128 + dk]);
#pragma unroll
              for (int jj = 0; jj < 4; ++jj) ((LAS bf16_t*)(lds + HG_ST))[(wave * 16 + kg * 4 + jj) * 136 + dk] = f2bf(st[n][jj] * e); } }
    }
    __syncthreads();
    if (OUT) {
        { const int mt = wave >> 1, n0 = (wave & 1) * 2;
          f32x4 s0 = (f32x4){0.f, 0.f, 0.f, 0.f}, s1 = s0;
#pragma unroll
          for (int ks = 0; ks < 4; ++ks) { const bf16x8 av = *(const LAS bf16x8*)(lds + HG_Q1 + (mt * 16 + r) * 272 + ks * 64 + kg * 16);
              const bf16x8 b0 = *(const LAS bf16x8*)(lds + HG_K1 + (n0 * 16 + r) * 272 + ks * 64 + kg * 16), b1 = *(const LAS bf16x8*)(lds + HG_K1 + ((n0 + 1) * 16 + r) * 272 + ks * 64 + kg * 16);
              s0 = MFMA16(av, b0, s0); s1 = MFMA16(av, b1, s1); }
#pragma unroll
          for (int jj = 0; jj < 4; ++jj) { const int t = mt * 16 + kg * 4 + jj; const int sA = n0 * 16 + r, sB = (n0 + 1) * 16 + r;
              const bool kA = DIR ? (sA >= t) : (sA <= t), kB = DIR ? (sB >= t) : (sB <= t);
              ((LAS bf16_t*)(lds + HG_PB))[t * 72 + sA] = kA ? f2bf(s0[jj]) : (bf16_t)0; ((LAS bf16_t*)(lds + HG_PB))[t * 72 + sB] = kB ? f2bf(s1[jj]) : (bf16_t)0; } }
        __syncthreads();
        { const int mt = wave >> 1, nv0 = (wave & 1) * 4;
#pragma unroll
          for (int ks2 = 0; ks2 < 2; ++ks2) { const bf16x8 av = *(const LAS bf16x8*)(lds + HG_PB + (mt * 16 + r) * 144 + ks2 * 64 + kg * 16);
#pragma unroll
              for (int i = 0; i < 4; ++i) { const bf16x8 bv = *(const LAS bf16x8*)(lds + HG_VT + ((nv0 + i) * 16 + r) * 144 + ks2 * 64 + kg * 16); oacc[i] = MFMA16(av, bv, oacc[i]); } }
#pragma unroll
          for (int ks = 0; ks < 4; ++ks) { const bf16x8 av = *(const LAS bf16x8*)(lds + HG_Q1 + (mt * 16 + r) * 272 + ks * 64 + kg * 16);
#pragma unroll
              for (int i = 0; i < 4; ++i) { const bf16x8 bv = *(const LAS bf16x8*)(lds + HG_ST + ((nv0 + i) * 16 + r) * 272 + ks * 64 + kg * 16); oacc[i] = MFMA16(av, bv, oacc[i]); } } }
    }
#pragma unroll
    for (int n = 0; n < 8; ++n) { const float e = eBL[n * 16 + r]; st[n] = st[n] * e; }
#pragma unroll
    for (int ks2 = 0; ks2 < 2; ++ks2) { const bf16x8 av = *(const LAS bf16x8*)(lds + HG_VT + (wave * 16 + r) * 144 + ks2 * 64 + kg * 16);
#pragma unroll
        for (int n = 0; n < 8; ++n) { const bf16x8 bv = *(const LAS bf16x8*)(lds + HG_KST + (n * 16 + r) * 144 + ks2 * 64 + kg * 16); st[n] = MFMA16(av, bv, st[n]); } }
    __syncthreads();
}

__device__ __forceinline__ float hg_lb(const Args& a, int dir, int h, int c) {
    const float l0 = a.lb_logits[(dir * 2 + 0) * 512 + h * 128 + c], l1 = a.lb_logits[(dir * 2 + 1) * 512 + h * 128 + c]; return __builtin_amdgcn_rcpf(1.f + __expf(l1 - l0)); }

__device__ void m1_hg_item(const Args& a, LAS unsigned char* lds, int rowbase, int h, int seqF, int slotF, int slotB) {
    const int tid = ltid(), lane = tid & 63, wave = tid >> 6, r = lane & 15, kg = lane >> 4, c = tid & 127;
    bf16_t* hgst = (bf16_t*)a.out + (size_t)1024 * 16384; float* hg_B = (float*)(a.ws + WS_SMALL + SM_HGB);
    f32x4 dummy[4]; f32x4 st[8]; StageRegs R;
    __syncthreads();
    if (slotF >= 0) {
        const float lb = hg_lb(a, 0, h, c); float bs = 0.f;
#pragma unroll
        for (int n = 0; n < 8; ++n) st[n] = (f32x4){0.f, 0.f, 0.f, 0.f};
        hg_fetch<0, false>(a, rowbase, h, R);
#pragma unroll 1
        for (int scu = 0; scu < 4; ++scu) hg_sub<0, false>(a, lds, scu < 3 ? rowbase + (scu + 1) * 64 : -1, h, lb, st, dummy, bs, R);
        bf16_t* dst = hgst + (size_t)(seqF * 16 + slotF) * 16384;
#pragma unroll
        for (int n = 0; n < 8; ++n)
#pragma unroll
            for (int jj = 0; jj < 4; ++jj) dst[(wave * 16 + kg * 4 + jj) * 128 + n * 16 + r] = f2bf(st[n][jj]);
        if (tid < 128) hg_B[(size_t)(seqF * 16 + slotF) * 128 + c] = bs;
    }
    if (slotB >= 0) {
        const float lb = hg_lb(a, 1, h, c); float bs = 0.f;
#pragma unroll
        for (int n = 0; n < 8; ++n) st[n] = (f32x4){0.f, 0.f, 0.f, 0.f};
        hg_fetch<1, false>(a, rowbase + 192, h, R);
#pragma unroll 1
        for (int scu = 0; scu < 4; ++scu) hg_sub<1, false>(a, lds, scu < 3 ? rowbase + (2 - scu) * 64 : -1, h, lb, st, dummy, bs, R);
        bf16_t* dst = hgst + (size_t)((seqF + 1) * 16 + slotB) * 16384;
#pragma unroll
        for (int n = 0; n < 8; ++n)
#pragma unroll
            for (int jj = 0; jj < 4; ++jj) dst[(wave * 16 + kg * 4 + jj) * 128 + n * 16 + r] = f2bf(st[n][jj]);
        if (tid < 128) hg_B[(size_t)((seqF + 1) * 16 + slotB) * 128 + c] = bs;
    }
}

__device__ void m3_hg_item(const Args& a, LAS unsigned char* lds, int q) {
    const int tid = ltid(), lane = tid & 63, wave = tid >> 6, r = lane & 15, kg = lane >> 4;
    const int b = q >> 6, h = (q >> 4) & 3, j = (q & 15) + 1;
    const int rowbase = b * 4096 + (j - 1) * 256;
    const bf16_t* P = (const bf16_t*)(a.ws + WS_P);
    const bf16_t* hgst = (const bf16_t*)a.out + (size_t)1024 * 16384;
    bf16_t* Y = (bf16_t*)(a.ws + WS_Y);
    const int seqF = (b * 4 + h) * 2, seqB = seqF + 1;
    const int slF = seqF * 16 + (j - 1), slB = seqB * 16 + (16 - j);
    const int c = tid & 127;
    const int mt = wave >> 1, hv = wave & 1;
    f32x4 st[8]; float bs = 0.f; StageRegs R;
    __syncthreads();
    {
        const float lb = hg_lb(a, 0, h, c);
        hg_fetch<0, true>(a, rowbase, h, R);
        const bf16_t* sp = hgst + (size_t)slF * 16384;
#pragma unroll
        for (int n = 0; n < 8; ++n)
#pragma unroll
            for (int jj = 0; jj < 4; ++jj) st[n][jj] = bf2f(sp[(wave * 16 + kg * 4 + jj) * 128 + n * 16 + r]);
#pragma unroll 1
        for (int scu = 0; scu < 4; ++scu) {
            f32x4 o[4];
#pragma unroll
            for (int i = 0; i < 4; ++i) o[i] = (f32x4){0.f, 0.f, 0.f, 0.f};
            const int rb = rowbase + scu * 64;
            hg_sub<0, true>(a, lds, scu < 3 ? rb + 64 : -1, h, lb, st, o, bs, R);
            { u32x4* pk = (u32x4*)(a.ws + WS_PARK + (size_t)lbid() * 65536) + (scu * NT + tid) * 2;
              pk[0] = (u32x4){pack2(o[0][0], o[0][1]), pack2(o[0][2], o[0][3]), pack2(o[1][0], o[1][1]), pack2(o[1][2], o[1][3])};
              pk[1] = (u32x4){pack2(o[2][0], o[2][1]), pack2(o[2][2], o[2][3]), pack2(o[3][0], o[3][1]), pack2(o[3][2], o[3][3])}; }
        }
    }
    {
        const float lb = hg_lb(a, 1, h, c);
        hg_fetch<1, true>(a, rowbase + 192, h, R);
        const bf16_t* sp = hgst + (size_t)slB * 16384;
        LAS float* ssq = (LAS float*)(lds + HG_MISC) + 1024;
#pragma unroll
        for (int n = 0; n < 8; ++n)
#pragma unroll
            for (int jj = 0; jj < 4; ++jj) st[n][jj] = bf2f(sp[(wave * 16 + kg * 4 + jj) * 128 + n * 16 + r]);
#pragma unroll 1
        for (int scu = 0; scu < 4; ++scu) {
            f32x4 o[4];
#pragma unroll
            for (int i = 0; i < 4; ++i) o[i] = (f32x4){0.f, 0.f, 0.f, 0.f};
            const int rb = rowbase + (3 - scu) * 64;
            hg_sub<1, true>(a, lds, scu < 3 ? rb - 64 : -1, h, lb, st, o, bs, R);
            const u32x4* pkp = (const u32x4*)(a.ws + WS_PARK + (size_t)lbid() * 65536) + ((3 - scu) * NT + tid) * 2; const u32x4 pk0 = pkp[0], pk1 = pkp[1];
#pragma unroll
            for (int jj = 0; jj < 4; ++jj) { float ss = 0.f;
#pragma unroll
                for (int i = 0; i < 4; ++i) { const unsigned pw = (i < 2 ? pk0 : pk1)[(i & 1) * 2 + (jj >> 1)]; const float v = o[i][jj] + ((jj & 1) ? hi_f(pw) : lo_f(pw)); o[i][jj] = v; ss += v * v; }
                ss = red16(ss); if (r == 0) ssq[(mt * 16 + kg * 4 + jj) * 2 + hv] = ss; }
            __syncthreads();
#pragma unroll
            for (int jj = 0; jj < 4; ++jj) { const int t = mt * 16 + kg * 4 + jj; const float rs = rsqrtf((ssq[t * 2] + ssq[t * 2 + 1]) * (1.f / 128.f) + 1e-6f);
#pragma unroll
                for (int i = 0; i < 4; ++i) { const int col = h * 128 + hv * 64 + i * 16 + r; const float g = bf2f(P[(size_t)(rb + t) * NPC + 4096 + col]);
                    Y[(size_t)(rb + t) * 1024 + 512 + col] = f2bf(o[i][jj] * rs * a.hg_norm_w[col] * g); } }
        }
    }
}

template <int DIR>
__device__ __forceinline__ void ml_fetch(const Args& a, int rb, int h, StageRegs& R) {
    const int tid = ltid(); const bf16_t* P = (const bf16_t*)(a.ws + WS_P); const bf16_t* QK = (const bf16_t*)(a.ws + WS_R1); const float* gates = (const float*)(a.ws + WS_GATES);
    const int s = tid >> 3, sg8 = tid & 7; const bf16_t* qp = QK + (size_t)(rb + s) * 1024 + h * 128 + sg8 * 16;
    R.b0 = *(const u32x4*)qp; R.b1 = *(const u32x4*)(qp + 8); R.a0 = *(const u32x4*)(qp + 512); R.a1 = *(const u32x4*)(qp + 520);
    const int s2 = tid & 63, cp = tid >> 6; const bf16_t* vp = P + (size_t)(rb + s2) * NPC + 1024 + h * 128 + cp * 16;
    R.v0 = *(const u32x4*)vp; R.v1 = *(const u32x4*)(vp + 8);
    if (tid < 64) { const float* g = gates + (size_t)(rb + tid) * 16; R.g0 = g[(DIR ? 12 : 4) + h]; R.g1 = g[(DIR ? 8 : 0) + h]; }
}
template <int DIR>
__device__ __forceinline__ void ml_sub(const Args& a, LAS unsigned char* lds, int rbn, int h, f32x4 (&st)[8], f32x4 (&hout)[4], StageRegs& R) {
    const int tid = ltid(), lane = tid & 63, wave = tid >> 6, r = lane & 15, kg = lane >> 4;
    LAS float* mf = (LAS float*)(lds + HG_MISC);
    LAS float *psum = mf, *nS = mf + 512, *lfA = mf + 640, *igA = mf + 704, *cA = mf + 768, *MA = mf + 832, *wiA = mf + 896, *flA = mf + 960, *wsA = mf + 1024, *scal = mf + 1088, *denP = mf + 1104, *qnP = mf + 1232;
    { const int s = tid >> 3, sg8 = tid & 7;
      *(LAS u32x4*)(lds + HG_Q1 + s * 272 + sg8 * 32) = R.b0; *(LAS u32x4*)(lds + HG_Q1 + s * 272 + sg8 * 32 + 16) = R.b1;
      *(LAS u32x4*)(lds + HG_K1 + s * 272 + sg8 * 32) = R.a0; *(LAS u32x4*)(lds + HG_K1 + s * 272 + sg8 * 32 + 16) = R.a1;
      stage_vT64(lds, tid, R.v0, R.v1);
      if (tid < 64) { lfA[tid] = logsig(R.g0); igA[tid] = R.g1; }
      if (rbn >= 0) ml_fetch<DIR>(a, rbn, h, R); }
    __syncthreads();
    if (tid < 64) { const int t = DIR ? 63 - lane : lane;
        const float l = lfA[t], ig = igA[t];
        const float b = wscan_add(l, lane); const float c = ig - b; const float gmx = wscan_max(c, lane);
        const float mprev = scal[1]; const float M = fmaxf(mprev, gmx);
        const float Btot = __shfl(b, 63), cmax = __shfl(gmx, 63); const float Mall = fmaxf(mprev, cmax);
        cA[t] = c; MA[t] = M; wiA[t] = __expf(mprev - M); flA[t] = __expf(-b - M); wsA[t] = __expf(c - Mall);
        if (lane == 0) { scal[0] = __expf(mprev - Mall); scal[2] = Btot + Mall; } }
    __syncthreads();
    { const int mt = wave >> 1, n0 = (wave & 1) * 2;
      f32x4 s0 = (f32x4){0.f, 0.f, 0.f, 0.f}, s1 = s0;
#pragma unroll
      for (int ks = 0; ks < 4; ++ks) { const bf16x8 av = *(const LAS bf16x8*)(lds + HG_Q1 + (mt * 16 + r) * 272 + ks * 64 + kg * 16);
          const bf16x8 b0 = *(const LAS bf16x8*)(lds + HG_K1 + (n0 * 16 + r) * 272 + ks * 64 + kg * 16), b1 = *(const LAS bf16x8*)(lds + HG_K1 + ((n0 + 1) * 16 + r) * 272 + ks * 64 + kg * 16);
          s0 = MFMA16(av, b0, s0); s1 = MFMA16(av, b1, s1); }
      const int sA = n0 * 16 + r, sB = sA + 16; const float cAv = cA[sA], cBv = cA[sB];
#pragma unroll
      for (int jj = 0; jj < 4; ++jj) { const int t = mt * 16 + kg * 4 + jj; const float Mt = MA[t];
          const bool kA = DIR ? (sA >= t) : (sA <= t), kB = DIR ? (sB >= t) : (sB <= t);
          const float pA = kA ? s0[jj] * __expf(cAv - Mt) : 0.f, pB = kB ? s1[jj] * __expf(cBv - Mt) : 0.f;
          ((LAS bf16_t*)(lds + HG_PB))[t * 72 + sA] = f2bf(pA); ((LAS bf16_t*)(lds + HG_PB))[t * 72 + sB] = f2bf(pB);
          const float ds = red16(pA + pB); if (r == 0) denP[t * 2 + (wave & 1)] = ds; } }
    { const int c = tid & 127, part = tid >> 7; float sm = 0.f;
#pragma unroll 4
      for (int i = 0; i < 16; ++i) { const int t = part * 16 + i; const float kw = bf2f(((const LAS bf16_t*)(lds + HG_K1))[t * 136 + c]) * wsA[t];
          ((LAS bf16_t*)(lds + HG_KST))[c * 72 + t] = f2bf(kw); sm += kw; }
      psum[part * 128 + c] = sm; }
    { const int t = tid & 63, p8 = tid >> 6; float acc = 0.f;
#pragma unroll 4
      for (int i = 0; i < 16; ++i) { const int dk = p8 * 16 + i; acc += bf2f(((const LAS bf16_t*)(lds + HG_Q1))[t * 136 + dk]) * nS[dk]; }
      qnP[p8 * 64 + t] = acc; }
#pragma unroll
    for (int n = 0; n < 8; ++n)
#pragma unroll
        for (int jj = 0; jj < 4; ++jj) ((LAS bf16_t*)(lds + HG_ST))[(wave * 16 + kg * 4 + jj) * 136 + n * 16 + r] = f2bf(st[n][jj]);
    __syncthreads();
    { const int mt = wave >> 1, nv0 = (wave & 1) * 4;
      f32x4 o1[4], o2[4];
#pragma unroll
      for (int i = 0; i < 4; ++i) { o1[i] = (f32x4){0.f, 0.f, 0.f, 0.f}; o2[i] = o1[i]; }
#pragma unroll
      for (int ks2 = 0; ks2 < 2; ++ks2) { const bf16x8 av = *(const LAS bf16x8*)(lds + HG_PB + (mt * 16 + r) * 144 + ks2 * 64 + kg * 16);
#pragma unroll
          for (int i = 0; i < 4; ++i) { const bf16x8 bv = *(const LAS bf16x8*)(lds + HG_VT + ((nv0 + i) * 16 + r) * 144 + ks2 * 64 + kg * 16); o1[i] = MFMA16(av, bv, o1[i]); } }
#pragma unroll
      for (int ks = 0; ks < 4; ++ks) { const bf16x8 av = *(const LAS bf16x8*)(lds + HG_Q1 + (mt * 16 + r) * 272 + ks * 64 + kg * 16);
#pragma unroll
          for (int i = 0; i < 4; ++i) { const bf16x8 bv = *(const LAS bf16x8*)(lds + HG_ST + ((nv0 + i) * 16 + r) * 272 + ks * 64 + kg * 16); o2[i] = MFMA16(av, bv, o2[i]); } }
#pragma unroll
      for (int jj = 0; jj < 4; ++jj) { const int t = mt * 16 + kg * 4 + jj; const float wi = wiA[t];
          float qn = 0.f;
#pragma unroll
          for (int p8 = 0; p8 < 8; ++p8) qn += qnP[p8 * 64 + t];
          const float den = denP[t * 2] + denP[t * 2 + 1] + wi * qn; const float inv = __builtin_amdgcn_rcpf(fmaxf(fabsf(den), flA[t]));
#pragma unroll
          for (int i = 0; i < 4; ++i) hout[i][jj] = (o1[i][jj] + wi * o2[i][jj]) * inv; } }
    const float decay = scal[0];
#pragma unroll
    for (int n = 0; n < 8; ++n) st[n] = st[n] * decay;
#pragma unroll
    for (int ks2 = 0; ks2 < 2; ++ks2) { const bf16x8 av = *(const LAS bf16x8*)(lds + HG_VT + (wave * 16 + r) * 144 + ks2 * 64 + kg * 16);
#pragma unroll
        for (int n = 0; n < 8; ++n) { const bf16x8 bv = *(const LAS bf16x8*)(lds + HG_KST + (n * 16 + r) * 144 + ks2 * 64 + kg * 16); st[n] = MFMA16(av, bv, st[n]); } }
    __syncthreads();
    if (tid < 128) nS[tid] = decay * nS[tid] + psum[tid] + psum[128 + tid] + psum[256 + tid] + psum[384 + tid];
    if (tid == 0) scal[1] = scal[2];
}

__device__ void m3_ml2_item(const Args& a, LAS unsigned char* lds, int q) {
    const int tid = ltid(), lane = tid & 63, wave = tid >> 6, r = lane & 15, kg = lane >> 4;
    const int b = q >> 6, h = (q >> 4) & 3, j = (q & 15) + 1;
    const int rowbase = b * 4096 + (j - 1) * 256;
    const bf16_t* P = (const bf16_t*)(a.ws + WS_P);
    const bf16_t* mlst = (const bf16_t*)a.out;
    const float* ml_n = (const float*)(a.ws + WS_SMALL + SM_MLN); const float* ml_mpre = (const float*)(a.ws + WS_SMALL + SM_MPRE);
    bf16_t* Y = (bf16_t*)(a.ws + WS_Y);
    LAS float* mf = (LAS float*)(lds + HG_MISC); LAS float *nS = mf + 512, *scal = mf + 1088, *ssq = mf + 1744;
    const int seqF = (b * 4 + h) * 2, seqB = seqF + 1;
    const int slF = seqF * 16 + (j - 1), slB = seqB * 16 + (16 - j);
    const int mt = wave >> 1, hv = wave & 1;
    f32x4 st[8]; StageRegs R;
    __syncthreads();
    {
        const bf16_t* sp = mlst + (size_t)slF * 16384;
#pragma unroll
        for (int n = 0; n < 8; ++n)
#pragma unroll
            for (int jj = 0; jj < 4; ++jj) st[n][jj] = bf2f(sp[(wave * 16 + kg * 4 + jj) * 128 + n * 16 + r]);
        if (tid < 128) nS[tid] = ml_n[(size_t)slF * 128 + tid];
        if (tid == 0) scal[1] = ml_mpre[slF];
        ml_fetch<0>(a, rowbase, h, R);
#pragma unroll 1
        for (int scu = 0; scu < 4; ++scu) { f32x4 ho[4]; const int rb = rowbase + scu * 64;
            ml_sub<0>(a, lds, scu < 3 ? rb + 64 : -1, h, st, ho, R);
            { u32x4* pk = (u32x4*)(a.ws + WS_PARK + (size_t)lbid() * 65536) + (scu * NT + tid) * 2;
              pk[0] = (u32x4){pack2(ho[0][0], ho[0][1]), pack2(ho[0][2], ho[0][3]), pack2(ho[1][0], ho[1][1]), pack2(ho[1][2], ho[1][3])};
              pk[1] = (u32x4){pack2(ho[2][0], ho[2][1]), pack2(ho[2][2], ho[2][3]), pack2(ho[3][0], ho[3][1]), pack2(ho[3][2], ho[3][3])}; } }
    }
    {
        const bf16_t* sp = mlst + (size_t)slB * 16384;
#pragma unroll
        for (int n = 0; n < 8; ++n)
#pragma unroll
            for (int jj = 0; jj < 4; ++jj) st[n][jj] = bf2f(sp[(wave * 16 + kg * 4 + jj) * 128 + n * 16 + r]);
        if (tid < 128) nS[tid] = ml_n[(size_t)slB * 128 + tid];
        if (tid == 0) scal[1] = ml_mpre[slB];
        ml_fetch<1>(a, rowbase + 192, h, R);
#pragma unroll 1
        for (int scu = 0; scu < 4; ++scu) { f32x4 ho[4]; const int rb = rowbase + (3 - scu) * 64;
            ml_sub<1>(a, lds, scu < 3 ? rb - 64 : -1, h, st, ho, R);
            const u32x4* pkp = (const u32x4*)(a.ws + WS_PARK + (size_t)lbid() * 65536) + ((3 - scu) * NT + tid) * 2; const u32x4 pk0 = pkp[0], pk1 = pkp[1];
#pragma unroll
            for (int jj = 0; jj < 4; ++jj) { float ss = 0.f;
#pragma unroll
                for (int i = 0; i < 4; ++i) { const unsigned pw = (i < 2 ? pk0 : pk1)[(i & 1) * 2 + (jj >> 1)]; const float v = ho[i][jj] + ((jj & 1) ? hi_f(pw) : lo_f(pw)); ho[i][jj] = v; ss += v * v; }
                ss = red16(ss); if (r == 0) ssq[(mt * 16 + kg * 4 + jj) * 2 + hv] = ss; }
            __syncthreads();
#pragma unroll
            for (int jj = 0; jj < 4; ++jj) { const int t = mt * 16 + kg * 4 + jj; const float rs = rsqrtf((ssq[t * 2] + ssq[t * 2 + 1]) * (1.f / 128.f) + 1e-6f);
#pragma unroll
                for (int i = 0; i < 4; ++i) { const int col = h * 128 + hv * 64 + i * 16 + r; const float og = bf2f(P[(size_t)(rb + t) * NPC + 1536 + col]);
                    Y[(size_t)(rb + t) * 1024 + col] = f2bf(ho[i][jj] * rs * a.ml_norm_w[col] * og); } }
        }
    }
}

__device__ void phase_m3(const Args& a, LAS unsigned char* lds) {
    for (int it = lbid(); it < 1024; it += gridDim.x) {
        if (it < 512) m3_ml2_item(a, lds, it); else m3_hg_item(a, lds, it - 512);
    }
}

#define XB_TMO      128
#define XB_XCNT(j)  (256  + 64 * (j))
#define XB_XSUB(j)  (1280 + 64 * (j))
#define XB_XGEN(j)  (2304 + 64 * (j))
#define XB_TOP      3328
#define XB_TOPGEN   3392
#define XCD_BAR_WORDS 3456
#define XB_SPIN_CAP (1u << 18)
__device__ __forceinline__ unsigned xb_ld(unsigned* p)              { return __hip_atomic_load(p, __ATOMIC_RELAXED, __HIP_MEMORY_SCOPE_AGENT); }
__device__ __forceinline__ unsigned xb_add(unsigned* p, unsigned v) { return __hip_atomic_fetch_add(p, v, __ATOMIC_RELAXED, __HIP_MEMORY_SCOPE_AGENT); }
__device__ __forceinline__ unsigned xb_xcc_id() { return (unsigned)__builtin_amdgcn_s_getreg((3 << 11) | 20) & 0xFu; }
#define XB_SPIN(cond, bar) do { unsigned _sp = 0; while (cond) { __builtin_amdgcn_s_sleep(1); \
    if ((++_sp & 255u) == 0u) { if (xb_ld(&(bar)[XB_TMO])) break; if (_sp > XB_SPIN_CAP) { atomicAdd(&(bar)[XB_TMO], 1u); break; } } } } while (0)
struct XcdBarrier { unsigned* bar; unsigned x; volatile LAS unsigned* st; };
__device__ __forceinline__ XcdBarrier xcd_barrier_post(unsigned* bar, volatile LAS unsigned* st) {
    XcdBarrier b; b.bar = bar; b.x = xb_xcc_id(); b.st = st;
    if (threadIdx.x == 0) (void)xb_add(&bar[XB_XCNT(b.x)], 1u);
    return b;
}
__device__ __forceinline__ void xcd_barrier_complete(unsigned* bar, unsigned x, unsigned& nloc, unsigned& nx) {
    const unsigned G = gridDim.x * gridDim.y * gridDim.z;
    unsigned sum, cnt, mine, sp = 0u;
    for (;;) {
        sum = 0u; cnt = 0u; mine = 0u;
#pragma unroll
        for (unsigned j = 0; j < 16; ++j) { const unsigned c = xb_ld(&bar[XB_XCNT(j)]); sum += c; cnt += (c > 0u) ? 1u : 0u; mine = (j == x) ? c : mine; }
        if (sum == G) break;
        __builtin_amdgcn_s_sleep(1);
        if ((++sp & 255u) == 0u) { if (xb_ld(&bar[XB_TMO])) break; if (sp > XB_SPIN_CAP) { atomicAdd(&bar[XB_TMO], 1u); break; } }
    }
    nloc = mine > 0u ? mine : 1u; nx = cnt > 0u ? cnt : 1u;
}
__device__ __forceinline__ void xcd_barrier(const XcdBarrier& b) {
    asm volatile("s_waitcnt vmcnt(0)" ::: "memory");
    __syncthreads();
    if (threadIdx.x == 0) {
        unsigned* bar = b.bar;
        __builtin_amdgcn_s_waitcnt(0);
        unsigned nloc = b.st[0], nx = b.st[1];
        if (nloc == 0u) { xcd_barrier_complete(bar, b.x, nloc, nx); b.st[0] = nloc; b.st[1] = nx; }
        const unsigned old = xb_add(&bar[XB_XSUB(b.x)], 1u);
        const unsigned gen = old / nloc;
        if (old + 1u == (gen + 1u) * nloc) {
            __builtin_amdgcn_fence(__ATOMIC_RELEASE, "agent");
            asm volatile("s_waitcnt vmcnt(0)" ::: "memory");
            const unsigned og = xb_add(&bar[XB_TOP], 1u);
            const unsigned tg = og / nx;
            if (og + 1u == (tg + 1u) * nx) xb_add(&bar[XB_TOPGEN], 1u);
            else XB_SPIN(xb_ld(&bar[XB_TOPGEN]) == tg, bar);
            __builtin_amdgcn_fence(__ATOMIC_ACQUIRE, "agent");
            xb_add(&bar[XB_XGEN(b.x)], 1u);
            asm volatile("s_waitcnt vmcnt(0)" ::: "memory");
        } else {
            XB_SPIN(xb_ld(&bar[XB_XGEN(b.x)]) == gen, bar);
            __builtin_amdgcn_fence(__ATOMIC_ACQUIRE, "agent");
            asm volatile("s_waitcnt vmcnt(0)" ::: "memory");
        }
    }
    __syncthreads();
}
constexpr size_t WS_BAR = WS_SMALL + 1536 * 1024;

constexpr int N_PHASES = 14;
__global__ void __launch_bounds__(NT, 2) mega(Args a) {
    extern __shared__ __attribute__((aligned(16))) unsigned char lds_raw[];
    LAS unsigned char* lds = (LAS unsigned char*)lds_raw;
    cg::grid_group grid = cg::this_grid();
    const int G = gridDim.x, bid = lbid();
    volatile LAS unsigned* stw = (volatile LAS unsigned*)(lds + LDS_BYTES - 16);
    if (threadIdx.x == 0) { stw[0] = 0u; stw[1] = 0u; }
    __syncthreads();
    const XcdBarrier bar = xcd_barrier_post((unsigned*)(a.ws + WS_BAR), stw);
    const int ph_lo = a.ph_lo, ph_hi = a.ph_hi;
    if (ph_lo < 0) grid.sync();
    for (int ph = ph_lo; ph < ph_hi; ++ph) {
        { __attribute__((address_space(1))) unsigned char* w = (__attribute__((address_space(1))) unsigned char*)a.ws; __attribute__((address_space(1))) float* o = (__attribute__((address_space(1))) float*)a.out;
          asm volatile("" : "+s"(w), "+s"(o)); a.ws = (unsigned char*)w; a.out = (float*)o; }
        switch (ph) {
        case 0: phase_p0(a, lds); break;
        case 1: phase_p1(a, lds); break;
        case 2: { pg8::Gemm g{(const bf16_t*)(a.ws + WS_R1), nullptr, 1 << 30, (const bf16_t*)(a.ws + WS_WIN), NROWS, NPC, 1024}; pg8::StaticOrder S; S.init(NROWS, NPC, G, bid);
                  pg8::EpiBf16<true> E{(bf16_t*)(a.ws + WS_P), NPC}; pg8::gemm_phase(lds, g, S, E); } break;
        case 3: phase_mc(a); break;
        case 4: phase_m1(a, lds); break;
        case 5: phase_m2(a); break;
        case 6: phase_m3(a, lds); break;
        case 7: { pg8::Gemm g{(const bf16_t*)(a.ws + WS_Y), nullptr, 1 << 30, (const bf16_t*)(a.ws + WS_WOUT), NLAT, 1024, 1024}; pg8::StaticOrder S; S.init(NLAT, 1024, G, bid);
                  pg8::EpiRes E{a.x, a.out, (const float*)(a.ws + WS_MOD) + 2048}; pg8::gemm_phase(lds, g, S, E); } break;
        case 8: phase_n2(a); break;
        case 9: { pg8::Gemm g{(const bf16_t*)(a.ws + WS_A2), nullptr, 1 << 30, (const bf16_t*)(a.ws + WS_WUP), NLAT, 5632, 1024}; pg8::StaticOrder S; S.init(NLAT, 5632, G, bid);
                  pg8::EpiBf16<false> E{(bf16_t*)(a.ws + WS_U), 5632}; pg8::gemm_phase(lds, g, S, E); } break;
        case 10: phase_cv(a, 0, (bf16_t*)(a.ws + WS_ACTA)); break;
        case 11: phase_cv(a, 4, (bf16_t*)(a.ws + WS_ACTB)); break;
        case 12: { pg8::Gemm g{(const bf16_t*)(a.ws + WS_ACTA), (const bf16_t*)(a.ws + WS_ACTB), 64, (const bf16_t*)(a.ws + WS_WDN), NLAT, 1024, 2816}; pg8::StaticOrder S; S.init(NLAT, 1024, G, bid);
                  pg8::EpiRes E{a.out, a.out, (const float*)(a.ws + WS_MOD) + 5120}; pg8::gemm_phase(lds, g, S, E); } break;
        case 13: phase_fn(a); break;
        }
        if (ph + 1 < ph_hi) xcd_barrier(bar);
    }
}

extern "C" void kernel_launch(void* const* d_in, const int* in_sizes, int n_in, void* d_out, int out_size, void* d_ws, size_t ws_size, hipStream_t stream) {
    static int grid = 0;
    if (grid == 0) {
        if (n_in != 19 || ws_size < WS_NEED) { fprintf(stderr, "kernel_launch: unexpected n_in %d / ws_size %zu\n", n_in, ws_size); grid = -1; return; }
        int dev = 0, cus = 0, per_cu = 0;
        (void)hipGetDevice(&dev); (void)hipDeviceGetAttribute(&cus, hipDeviceAttributeMultiprocessorCount, dev);
        if (hipFuncSetAttribute((const void*)mega, hipFuncAttributeMaxDynamicSharedMemorySize, LDS_BYTES) != hipSuccess) { fprintf(stderr, "kernel_launch: hipFuncSetAttribute failed\n"); grid = -1; return; }
        if (hipOccupancyMaxActiveBlocksPerMultiprocessor(&per_cu, (const void*)mega, NT, LDS_BYTES) != hipSuccess || per_cu < 1) { fprintf(stderr, "kernel_launch: occupancy query says %d\n", per_cu); per_cu = 1; }
        (void)hipGetLastError();
        grid = cus;
    }
    if (grid < 0) return;
    Args a{};
    const float** ip = (const float**)&a;
    for (int i = 0; i < 19; ++i) ip[i] = (const float*)d_in[i];
    a.out = (float*)d_out; a.ws = (unsigned char*)d_ws;
    (void)hipMemsetAsync((unsigned char*)d_ws + WS_BAR, 0, XCD_BAR_WORDS * sizeof(unsigned), stream);
    a.ph_lo = 0; a.ph_hi = N_PHASES; void* args[] = {&a};
    hipError_t e = hipLaunchCooperativeKernel((const void*)mega, dim3(grid), dim3(NT), args, LDS_BYTES, stream);
    if (e != hipSuccess) fprintf(stderr, "cooperative launch failed: %s (grid %d)\n", hipGetErrorString(e), grid);
}
```

```cpp
#include <hip/hip_runtime.h>
#include <hip/hip_cooperative_groups.h>
#include <cstdio>
namespace cg = cooperative_groups;

#define LAS __attribute__((address_space(3)))
typedef unsigned short bf16_t;
typedef short bf16x8 __attribute__((ext_vector_type(8)));
typedef float f32x4 __attribute__((ext_vector_type(4)));
typedef float f32x2 __attribute__((ext_vector_type(2)));
typedef unsigned u32x4 __attribute__((ext_vector_type(4)));
typedef unsigned u32x2 __attribute__((ext_vector_type(2)));


constexpr int NT = 512;
constexpr int LDS_BYTES = 147456;
constexpr size_t MiB = 1048576;
constexpr int NROWS = 34816, NLAT = 32768, NPC = 4608;
constexpr size_t WS_WIN = 0, WS_WOUT = 9 * MiB, WS_WUP = 11 * MiB, WS_WDN = 22 * MiB, WS_MOD = 28 * MiB, WS_GATES = 29 * MiB, WS_SMALL = 32 * MiB;
constexpr size_t WS_R1 = 34 * MiB, WS_P = 102 * MiB, WS_Y = 408 * MiB, WS_U = 34 * MiB, WS_A2 = 448 * MiB, WS_ACTA = 386 * MiB, WS_ACTB = 34 * MiB, WS_NEED = 512 * MiB;
constexpr size_t WS_PARK = 472 * MiB;
constexpr size_t SM_MLN = 0, SM_HGB = 512 * 1024, SM_MLOC = 1024 * 1024, SM_MLB = 1024 * 1024 + 4096, SM_MPRE = 1024 * 1024 + 8192;

struct Args {
    const float *x, *c, *ctx, *c_ctx, *w_mod, *b_mod, *norm1_w, *w_in, *gate_b, *ml_conv_w, *ml_norm_w, *lb_logits, *hg_norm_w, *w_out, *norm2_w, *w_up, *ffn_conv_w, *w_down, *final_w;
    float* out; unsigned char* ws; int ph_lo, ph_hi;
};

__device__ __forceinline__ float bf2f(unsigned short h) { return __uint_as_float(((unsigned)h) << 16); }
typedef __bf16 bf16x2n __attribute__((ext_vector_type(2)));
__device__ __forceinline__ unsigned pack2(float lo, float hi) { const f32x2 v = {lo, hi}; return __builtin_bit_cast(unsigned, __builtin_convertvector(v, bf16x2n)); }
__device__ __forceinline__ unsigned short f2bf(float f) { return (unsigned short)pack2(f, f); }
__device__ __forceinline__ float lo_f(unsigned u) { return __uint_as_float(u << 16); }
__device__ __forceinline__ float hi_f(unsigned u) { return __uint_as_float(u & 0xffff0000u); }
__device__ __forceinline__ float sigm(float x) { return __builtin_amdgcn_rcpf(1.f + __expf(-x)); }
__device__ __forceinline__ float silu(float x) { return x * __builtin_amdgcn_rcpf(1.f + __expf(-x)); }
__device__ __forceinline__ float logsig(float x) { return fminf(x, 0.f) - log1pf(__expf(-fabsf(x))); }
__device__ __forceinline__ float wsum(float v) {
#pragma unroll
    for (int o = 32; o; o >>= 1) v += __shfl_xor(v, o); return v; }
__device__ __forceinline__ float wmaxr(float v) {
#pragma unroll
    for (int o = 32; o; o >>= 1) v = fmaxf(v, __shfl_xor(v, o)); return v; }
__device__ __forceinline__ float wscan_add(float v, int lane) {
#pragma unroll
    for (int o = 1; o < 64; o <<= 1) { float t = __shfl_up(v, o); if (lane >= o) v += t; } return v; }
__device__ __forceinline__ float wscan_max(float v, int lane) {
#pragma unroll
    for (int o = 1; o < 64; o <<= 1) { float t = __shfl_up(v, o); if (lane >= o) v = fmaxf(v, t); } return v; }
__device__ __forceinline__ float red16(float v) { v += __shfl_xor(v, 1); v += __shfl_xor(v, 2); v += __shfl_xor(v, 4); v += __shfl_xor(v, 8); return v; }
__device__ __forceinline__ void wave_lds_sync() { __builtin_amdgcn_fence(__ATOMIC_RELEASE, "workgroup"); __builtin_amdgcn_wave_barrier(); __builtin_amdgcn_fence(__ATOMIC_ACQUIRE, "workgroup"); }
__device__ __forceinline__ int ltid() { int t = threadIdx.x; asm volatile("" : "+v"(t)); return t; }
__device__ __forceinline__ int lbid() { int t = blockIdx.x; asm volatile("" : "+s"(t)); return t; }
#define MFMA16(a, b, c) __builtin_amdgcn_mfma_f32_16x16x32_bf16((a), (b), (c), 0, 0, 0)

namespace pg8 {
constexpr int BM = 256, BK = 64, HALF = 128, HTB = HALF * BK * 2, STAGE_BYTES = 8 * HTB, NXCD = 8, WGM = 2;
__device__ __forceinline__ int lds_byte(int r, int c) { const int st = (r >> 4) * 2 + (c >> 5), rr = r & 15, cc = c & 31, ob = rr * 64 + cc * 2; return st * 1024 + (ob ^ (((ob >> 9) & 1) << 5)); }
__device__ __forceinline__ void stage_rc(int b, int& R, int& C) { const int st = b / 1024, sb = b % 1024, swz = sb ^ (((sb >> 9) & 1) << 5); R = (st >> 1) * 16 + swz / 64; C = (st & 1) * 32 + (swz % 64) / 2; }
__device__ __forceinline__ int perm32(int rho) { const int n = rho >> 4, i = rho & 15; return 8 * (i >> 2) + 4 * n + (i & 3); }
struct Unit { int pm, pn; };
struct Gemm { const bf16_t* A; const bf16_t* A_hi; int pm_split; const bf16_t* Bt; int M, N, K; };
struct StaticOrder {
    int nM, nN, nwg, G, c;
    __device__ void init(int M, int N, int G_, int c_) { nM = M / BM; nN = N / BM; nwg = nM * nN; G = G_; c = c_; }
    __device__ bool next(int i, Unit& u) const {
        const long L = (long)i * G + c; if (L >= nwg) return false;
        int wgid = (int)L; { const int q = nwg / NXCD, r = nwg % NXCD, xcd = wgid % NXCD, off = wgid / NXCD; wgid = (xcd < r ? xcd * (q + 1) : r * (q + 1) + (xcd - r) * q) + off; }
        const int nig = WGM * nN, gid = wgid / nig, fm = gid * WGM, gsz = (nM - fm) < WGM ? (nM - fm) : WGM;
        u.pm = fm + ((wgid % nig) % gsz); u.pn = (wgid % nig) / gsz; return true;
    }
};
__device__ __forceinline__ unsigned cvt_pk_bf16(float lo, float hi) { return pack2(lo, hi); }

template <bool ACT> struct EpiBf16 {
    static constexpr bool PERM = true;
    bf16_t* O; int ldc;
    __device__ __forceinline__ f32x4 act(f32x4 v, int mode) const {
        if (!ACT || mode == 0) return v;
        f32x4 o;
#pragma unroll
        for (int j = 0; j < 4; ++j) { const float s = __builtin_amdgcn_rcpf(1.f + __expf(-v[j])); o[j] = mode == 1 ? s : (mode == 2 ? v[j] * s * 0.08838834764831845f : v[j] * s); }
        return o; }
    __device__ __forceinline__ void operator()(const f32x4 (&acc)[2][2][4][2], const Unit& u, int wr, int wc, int fr, int fq) const {
        const int mode = !ACT ? 0 : ((u.pn == 6 || u.pn == 7) ? 1 : ((u.pn == 8 || u.pn == 9) ? 2 : ((u.pn == 16 || u.pn == 17) ? 3 : 0)));
        const int row0 = u.pm * BM + wr * 64 + fr; const int col0 = u.pn * BM + wc * 32 + 8 * fq;
#pragma unroll
        for (int ai = 0; ai < 2; ++ai)
#pragma unroll
            for (int m = 0; m < 4; ++m) { bf16_t* rowp = O + (size_t)(row0 + ai * HALF + m * 16) * ldc + col0;
#pragma unroll
                for (int bj = 0; bj < 2; ++bj) { const f32x4 v0 = act(acc[ai][bj][m][0], mode), v1 = act(acc[ai][bj][m][1], mode);
                    u32x4 w; w.x = cvt_pk_bf16(v0[0], v0[1]); w.y = cvt_pk_bf16(v0[2], v0[3]); w.z = cvt_pk_bf16(v1[0], v1[1]); w.w = cvt_pk_bf16(v1[2], v1[3]);
                    __builtin_nontemporal_store(w, (u32x4*)(rowp + bj * HALF)); } }
    }
};
struct EpiRes {
    static constexpr bool PERM = false;
    const float* base; float* out; const float* gate;
    __device__ __forceinline__ void operator()(const f32x4 (&acc)[2][2][4][2], const Unit& u, int wr, int wc, int fr, int fq) const {
        const int row0 = u.pm * BM + wr * 64 + fr, col0 = u.pn * BM + wc * 32 + 4 * fq;
        const float* gp = gate + (size_t)(u.pm >> 4) * 6144 + col0;
        f32x4 gv[2][2];
#pragma unroll
        for (int bj = 0; bj < 2; ++bj)
#pragma unroll
            for (int n = 0; n < 2; ++n) gv[bj][n] = *(const f32x4*)(gp + bj * HALF + n * 16);
#pragma unroll
        for (int ai = 0; ai < 2; ++ai)
#pragma unroll
            for (int m = 0; m < 4; ++m) { const size_t ro = (size_t)(row0 + ai * HALF + m * 16) * 1024 + col0;
#pragma unroll
                for (int bj = 0; bj < 2; ++bj)
#pragma unroll
                    for (int n = 0; n < 2; ++n) { f32x4 b = *(const f32x4*)(base + ro + bj * HALF + n * 16); __builtin_nontemporal_store(b + gv[bj][n] * acc[ai][bj][m][n], (f32x4*)(out + ro + bj * HALF + n * 16)); } }
    }
};

template <class Epi, bool ALIGN_EPI = true, bool SP2 = true>
__device__ __forceinline__ void gemm_phase(LAS unsigned char* lds, const Gemm g, const StaticOrder& S, const Epi& E) {
    const int tid = ltid(), wid = __builtin_amdgcn_readfirstlane(tid >> 6), lane = tid & 63, wr = wid >> 2, wc = wid & 3, fr = lane & 15, fq = lane >> 4;
    const int K = g.K, nt = K / BK;
    unsigned voffA[2], voffB[2];
#pragma unroll
    for (int i = 0; i < 2; ++i) { int R, C; stage_rc(tid * 16 + i * 8192, R, C); const int Rb = Epi::PERM ? ((R & ~31) + perm32(R & 31)) : R;
        voffA[i] = (unsigned)(R * K + C) * 2u; voffB[i] = (unsigned)(Rb * K + C) * 2u; }
    const size_t kstep = (size_t)(BK * 2);
    const size_t hstep = (size_t)HALF * K * 2;
    const size_t tstep = 2 * hstep;
    const unsigned ldsw = (unsigned)wid * 1024u;
    const int aoff = lds_byte(wr * 64 + fr, fq * 8), boff = lds_byte(wc * 32 + fr, fq * 8);
#define PG8_APTR(pm) ((pm) < g.pm_split ? (const char*)g.A + (size_t)(pm) * tstep : (const char*)g.A_hi + (size_t)((pm) - g.pm_split) * tstep)
#define PG8_SA(b, h) (((b) * 2 + (h)) * HTB)
#define PG8_SB(b, h) ((4 + (b) * 2 + (h)) * HTB)
#define PG8_STAGE(bufoff, gbase, voff) do { _Pragma("unroll") for (int _i = 0; _i < 2; ++_i) \
        __builtin_amdgcn_global_load_lds((const unsigned*)((const char*)(gbase) + (voff)[_i]), (LAS unsigned*)(lds + (bufoff) + ldsw + _i * 8192), 16, 0, 0); } while (0)
#define PG8_LDA(dst, b, h) do { _Pragma("unroll") for (int m = 0; m < 4; ++m) _Pragma("unroll") for (int k = 0; k < 2; ++k) dst[m][k] = *(const LAS bf16x8*)(lds + PG8_SA(b, h) + aoff + m * 2048 + k * 1024); } while (0)
#define PG8_LDB(dst, b, h) do { _Pragma("unroll") for (int n = 0; n < 2; ++n) _Pragma("unroll") for (int k = 0; k < 2; ++k) dst[n][k] = *(const LAS bf16x8*)(lds + PG8_SB(b, h) + boff + n * 2048 + k * 1024); } while (0)
#define PG8_MMA(ai, bj, At, Bt) do { __builtin_amdgcn_s_setprio(1); _Pragma("unroll") for (int m = 0; m < 4; ++m) _Pragma("unroll") for (int n = 0; n < 2; ++n) _Pragma("unroll") for (int k = 0; k < 2; ++k) \
        acc[ai][bj][m][n] = __builtin_amdgcn_mfma_f32_16x16x32_bf16(Bt[n][k], At[m][k], acc[ai][bj][m][n], 0, 0, 0); __builtin_amdgcn_s_setprio(0); } while (0)
#define PG8_WAIT_V(n) asm volatile("s_waitcnt vmcnt(" #n ")" ::: "memory")
#define PG8_WAIT_L(n) asm volatile("s_waitcnt lgkmcnt(" #n ")" ::: "memory")
#define PG8_BAR __builtin_amdgcn_s_barrier()
#define PG8_SCHED __builtin_amdgcn_sched_barrier(0)
    Unit cur, nxt; int ui = 0;
    if (!S.next(0, cur)) return;
    f32x4 acc[2][2][4][2];
#pragma unroll
    for (int a = 0; a < 2; ++a)
#pragma unroll
        for (int b = 0; b < 2; ++b)
#pragma unroll
            for (int m = 0; m < 4; ++m)
#pragma unroll
                for (int n = 0; n < 2; ++n) acc[a][b][m][n] = (f32x4){0.f, 0.f, 0.f, 0.f};
    bf16x8 At[4][2], B0[2][2], B1[2][2];
    const char* cA = PG8_APTR(cur.pm); const char* cB = (const char*)g.Bt + (size_t)cur.pn * tstep;
    if constexpr (SP2) {
        PG8_STAGE(PG8_SB(0, 0), cB, voffB); PG8_STAGE(PG8_SB(0, 1), cB + hstep, voffB); PG8_STAGE(PG8_SA(0, 0), cA, voffA); PG8_STAGE(PG8_SA(0, 1), cA + hstep, voffA);
        if (wr == 1) PG8_BAR;
        PG8_WAIT_V(2); PG8_BAR;
        PG8_STAGE(PG8_SB(1, 0), cB + kstep, voffB); PG8_STAGE(PG8_SA(1, 0), cA + kstep, voffA); PG8_STAGE(PG8_SB(1, 1), cB + hstep + kstep, voffB);
        PG8_WAIT_V(6); PG8_BAR;
    } else {
        PG8_STAGE(PG8_SB(0, 0), cB, voffB); PG8_STAGE(PG8_SA(0, 0), cA, voffA); PG8_STAGE(PG8_SB(0, 1), cB + hstep, voffB); PG8_STAGE(PG8_SA(0, 1), cA + hstep, voffA);
        if (wr == 1) PG8_BAR;
        PG8_WAIT_V(4); PG8_BAR;
        PG8_STAGE(PG8_SB(1, 0), cB + kstep, voffB); PG8_STAGE(PG8_SA(1, 0), cA + kstep, voffA); PG8_STAGE(PG8_SB(1, 1), cB + hstep + kstep, voffB);
        PG8_WAIT_V(6); PG8_BAR;
    }
    for (;;) {
        const bool has_next = S.next(ui + 1, nxt);
        const char* nA = has_next ? PG8_APTR(nxt.pm) : cA; const char* nB = has_next ? (const char*)g.Bt + (size_t)nxt.pn * tstep : cB;
        for (int t = 0; t < nt; t += 2) {
            const bool last = (t == nt - 2);
            const char* a1 = cA + (size_t)(t + 1) * kstep;
            const char* a2 = last ? nA : cA + (size_t)(t + 2) * kstep; const char* b2 = last ? nB : cB + (size_t)(t + 2) * kstep;
            const char* a3 = a2 + kstep; const char* b3 = b2 + kstep;
            if constexpr (SP2) {
            PG8_LDB(B0, 0, 0); PG8_LDB(B1, 0, 1); PG8_SCHED; PG8_LDA(At, 0, 0); PG8_STAGE(PG8_SA(1, 1), a1 + hstep, voffA);
            PG8_WAIT_V(8); PG8_WAIT_L(0); PG8_BAR; PG8_MMA(0, 0, At, B0); PG8_MMA(0, 1, At, B1); PG8_BAR; PG8_SCHED;
            PG8_LDA(At, 0, 1); PG8_STAGE(PG8_SB(0, 0), b2, voffB); PG8_STAGE(PG8_SB(0, 1), b2 + hstep, voffB); PG8_STAGE(PG8_SA(0, 0), a2, voffA);
            PG8_WAIT_V(8); PG8_WAIT_L(0); PG8_BAR; PG8_MMA(1, 0, At, B0); PG8_MMA(1, 1, At, B1); PG8_BAR; PG8_SCHED;
            PG8_LDB(B0, 1, 0); PG8_LDB(B1, 1, 1); PG8_SCHED; PG8_LDA(At, 1, 0); PG8_STAGE(PG8_SA(0, 1), a2 + hstep, voffA);
            PG8_WAIT_V(8); PG8_WAIT_L(0); PG8_BAR; PG8_MMA(0, 0, At, B0); PG8_MMA(0, 1, At, B1); PG8_BAR; PG8_SCHED;
            PG8_LDA(At, 1, 1); PG8_STAGE(PG8_SB(1, 0), b3, voffB); PG8_STAGE(PG8_SB(1, 1), b3 + hstep, voffB); PG8_STAGE(PG8_SA(1, 0), a3, voffA);
            PG8_WAIT_V(8); PG8_WAIT_L(0); PG8_BAR; PG8_MMA(1, 0, At, B0); PG8_MMA(1, 1, At, B1); PG8_BAR; PG8_SCHED;
            } else {
            PG8_LDB(B0, 0, 0); PG8_SCHED; PG8_LDA(At, 0, 0); PG8_STAGE(PG8_SA(1, 1), a1 + hstep, voffA);
            PG8_WAIT_L(8); PG8_BAR; PG8_WAIT_L(0); PG8_MMA(0, 0, At, B0); PG8_BAR; PG8_SCHED;
            PG8_LDB(B1, 0, 1); PG8_STAGE(PG8_SB(0, 0), b2, voffB);
            PG8_BAR; PG8_WAIT_L(0); PG8_MMA(0, 1, At, B1); PG8_BAR;
            PG8_LDA(At, 0, 1); PG8_STAGE(PG8_SA(0, 0), a2, voffA);
            PG8_BAR; PG8_WAIT_L(0); PG8_MMA(1, 0, At, B0); PG8_BAR; PG8_SCHED;
            PG8_STAGE(PG8_SB(0, 1), b2 + hstep, voffB);
            PG8_WAIT_V(6); PG8_BAR; PG8_MMA(1, 1, At, B1); PG8_BAR;
            PG8_LDB(B0, 1, 0); PG8_SCHED; PG8_LDA(At, 1, 0); PG8_STAGE(PG8_SA(0, 1), a2 + hstep, voffA);
            PG8_WAIT_L(8); PG8_BAR; PG8_WAIT_L(0); PG8_MMA(0, 0, At, B0); PG8_BAR; PG8_SCHED;
            PG8_LDB(B1, 1, 1); PG8_STAGE(PG8_SB(1, 0), b3, voffB);
            PG8_BAR; PG8_WAIT_L(0); PG8_MMA(0, 1, At, B1); PG8_BAR;
            PG8_LDA(At, 1, 1); PG8_STAGE(PG8_SA(1, 0), a3, voffA);
            PG8_BAR; PG8_WAIT_L(0); PG8_MMA(1, 0, At, B0); PG8_BAR; PG8_SCHED;
            PG8_STAGE(PG8_SB(1, 1), b3 + hstep, voffB);
            PG8_WAIT_V(6); PG8_BAR; PG8_MMA(1, 1, At, B1); PG8_BAR;
            }
        }
        if constexpr (ALIGN_EPI) { if (wr == 0) PG8_BAR; }
        E(acc, cur, wr, wc, fr, fq);
        if (!has_next) break;
#pragma unroll
        for (int a = 0; a < 2; ++a)
#pragma unroll
            for (int b = 0; b < 2; ++b)
#pragma unroll
                for (int m = 0; m < 4; ++m)
#pragma unroll
                    for (int n = 0; n < 2; ++n) acc[a][b][m][n] = (f32x4){0.f, 0.f, 0.f, 0.f};
        cur = nxt; cA = nA; cB = nB; ++ui;
        if constexpr (ALIGN_EPI) { if (wr == 1) PG8_BAR; }
    }
    PG8_WAIT_V(0);
    if constexpr (!ALIGN_EPI) { if (wr == 0) PG8_BAR; }
    PG8_BAR;
#undef PG8_APTR
#undef PG8_SA
#undef PG8_SB
#undef PG8_STAGE
#undef PG8_LDA
#undef PG8_LDB
#undef PG8_MMA
#undef PG8_WAIT_V
#undef PG8_WAIT_L
#undef PG8_BAR
#undef PG8_SCHED
}
}

__device__ void phase_p0(const Args& a, LAS unsigned char* lds) {
    const int tid = ltid();
    float* mod = (float*)(a.ws + WS_MOD);
    for (int it = lbid(); it < 192; it += gridDim.x) {
        LAS float* sS = (LAS float*)lds; LAS float* red = sS + 9 * 1024;
        for (int e = tid; e < 9 * 1024; e += NT) { const int i = e >> 10, k = e & 1023; const float v = (i < 8) ? a.c[i * 1024 + k] : a.c_ctx[k]; sS[e] = silu(v); }
        __syncthreads();
        const int col = tid & 31, ks = tid >> 5, j = it * 32 + col;
        float acc[9];
#pragma unroll
        for (int i = 0; i < 9; ++i) acc[i] = 0.f;
#pragma unroll 1
        for (int k8 = 0; k8 < 64; k8 += 16) { float w[16];
#pragma unroll
            for (int kk = 0; kk < 16; ++kk) w[kk] = a.w_mod[(size_t)(ks * 64 + k8 + kk) * 6144 + j];
#pragma unroll
            for (int kk = 0; kk < 16; ++kk) { const int k = ks * 64 + k8 + kk;
#pragma unroll
                for (int i = 0; i < 9; ++i) acc[i] += sS[i * 1024 + k] * w[kk]; } }
#pragma unroll
        for (int i = 0; i < 9; ++i) red[(ks * 9 + i) * 32 + col] = acc[i];
        __syncthreads();
        if (tid < 288) { const int i = tid >> 5, cc = tid & 31; float s = 0.f; for (int q = 0; q < 16; ++q) s += red[(q * 9 + i) * 32 + cc]; mod[i * 6144 + it * 32 + cc] = s + a.b_mod[it * 32 + cc]; }
        __syncthreads();
    }
    LAS float* tile = (LAS float*)lds;
    auto decode = [&](int tt, const float*& src, bf16_t*& dst, int& K, int& Ns, int& kt, int& ntl, int& scol) {
        if (tt < 1152) { src = a.w_in; dst = (bf16_t*)(a.ws + WS_WIN); K = 1024; Ns = 4624; kt = tt & 15; ntl = tt >> 4; scol = ntl * 64; if (scol >= 2048) scol += 16; }
        else if (tt < 1408) { const int u = tt - 1152; src = a.w_out; dst = (bf16_t*)(a.ws + WS_WOUT); K = 1024; Ns = 1024; kt = u & 15; ntl = u >> 4; scol = ntl * 64; }
        else if (tt < 2816) { const int u = tt - 1408; src = a.w_up; dst = (bf16_t*)(a.ws + WS_WUP); K = 1024; Ns = 5632; kt = u & 15; ntl = u >> 4; scol = ntl * 64; }
        else { const int u = tt - 2816; src = a.w_down; dst = (bf16_t*)(a.ws + WS_WDN); K = 2816; Ns = 1024; kt = u % 44; ntl = u / 44; scol = ntl * 64; } };
    const int tkk = tid >> 4, tn4 = (tid & 15) * 4;
    auto ldtile = [&](int tt, f32x4& v0, f32x4& v1) { const float* src; bf16_t* dst; int K, Ns, kt, ntl, scol; decode(tt, src, dst, K, Ns, kt, ntl, scol);
        v0 = *(const f32x4*)(src + (size_t)(kt * 64 + tkk) * Ns + scol + tn4); v1 = *(const f32x4*)(src + (size_t)(kt * 64 + tkk + 32) * Ns + scol + tn4); };
    f32x4 c0, c1, n0, n1; int tt = lbid();
    if (tt < 3520) ldtile(tt, c0, c1);
    for (; tt < 3520; tt += gridDim.x) {
        const int tnx = tt + gridDim.x; if (tnx < 3520) ldtile(tnx, n0, n1);
        const float* src; bf16_t* dst; int K, Ns, kt, ntl, scol; decode(tt, src, dst, K, Ns, kt, ntl, scol);
        tile[tkk * 65 + tn4] = c0[0]; tile[tkk * 65 + tn4 + 1] = c0[1]; tile[tkk * 65 + tn4 + 2] = c0[2]; tile[tkk * 65 + tn4 + 3] = c0[3];
        tile[(tkk + 32) * 65 + tn4] = c1[0]; tile[(tkk + 32) * 65 + tn4 + 1] = c1[1]; tile[(tkk + 32) * 65 + tn4 + 2] = c1[2]; tile[(tkk + 32) * 65 + tn4 + 3] = c1[3];
        __syncthreads();
        { const int n = tid >> 3, k8 = (tid & 7) * 8; u32x4 w;
          w.x = pack2(tile[(k8 + 0) * 65 + n], tile[(k8 + 1) * 65 + n]); w.y = pack2(tile[(k8 + 2) * 65 + n], tile[(k8 + 3) * 65 + n]);
          w.z = pack2(tile[(k8 + 4) * 65 + n], tile[(k8 + 5) * 65 + n]); w.w = pack2(tile[(k8 + 6) * 65 + n], tile[(k8 + 7) * 65 + n]);
          *(u32x4*)(dst + (size_t)(ntl * 64 + n) * K + kt * 64 + k8) = w; }
        __syncthreads();
        c0 = n0; c1 = n1;
    }
}

__device__ void phase_p1(const Args& a, LAS unsigned char* lds) {
    const int tid = ltid(), lane = tid & 63, wave = tid >> 6;
    LAS float* wgT = (LAS float*)lds;
    for (int e = tid; e < 16384; e += NT) { const int k = e >> 4, j = e & 15; wgT[j * 1024 + k] = a.w_in[(size_t)k * 4624 + 2048 + j]; }
    __syncthreads();
    const float* mod = (const float*)(a.ws + WS_MOD);
    bf16_t* A1 = (bf16_t*)(a.ws + WS_R1);
    float* gates = (float*)(a.ws + WS_GATES);
    const int rstep = gridDim.x * 8;
    for (int row0 = lbid() * 8 + wave; row0 < NROWS; row0 += 2 * rstep) {
        const int row1r = row0 + rstep; const bool has1 = row1r < NROWS; const int row1 = has1 ? row1r : row0;
        const float* src0 = row0 < NLAT ? a.x + (size_t)row0 * 1024 : a.ctx + (size_t)(row0 - NLAT) * 1024;
        const float* src1 = row1 < NLAT ? a.x + (size_t)row1 * 1024 : a.ctx + (size_t)(row1 - NLAT) * 1024;
        const float* mb0 = mod + (row0 < NLAT ? (row0 >> 12) : 8) * 6144; const float* mb1 = mod + (row1 < NLAT ? (row1 >> 12) : 8) * 6144;
        float ss0 = 0.f, ss1 = 0.f;
#pragma unroll
        for (int i = 0; i < 8; ++i) { const f32x2 x0 = *(const f32x2*)(src0 + i * 128 + lane * 2), x1 = *(const f32x2*)(src1 + i * 128 + lane * 2); ss0 += x0.x * x0.x + x0.y * x0.y; ss1 += x1.x * x1.x + x1.y * x1.y; }
        ss0 = wsum(ss0); ss1 = wsum(ss1);
        const float rs0 = rsqrtf(ss0 * (1.f / 1024.f) + 1e-6f), rs1 = rsqrtf(ss1 * (1.f / 1024.f) + 1e-6f);
        float g0[16], g1[16];
#pragma unroll
        for (int j = 0; j < 16; ++j) { g0[j] = 0.f; g1[j] = 0.f; }
        f32x2 xv0 = *(const f32x2*)(src0 + lane * 2), xv1 = *(const f32x2*)(src1 + lane * 2), nw = *(const f32x2*)(a.norm1_w + lane * 2);
        f32x2 sh0 = *(const f32x2*)(mb0 + lane * 2), sc0 = *(const f32x2*)(mb0 + 1024 + lane * 2), sh1 = *(const f32x2*)(mb1 + lane * 2), sc1 = *(const f32x2*)(mb1 + 1024 + lane * 2);
#pragma unroll 1
        for (int i = 0; i < 8; ++i) { const int k = i * 128 + lane * 2; const int kn = ((i + 1) & 7) * 128 + lane * 2;
            const f32x2 xn0 = *(const f32x2*)(src0 + kn), xn1 = *(const f32x2*)(src1 + kn), nwn = *(const f32x2*)(a.norm1_w + kn);
            const f32x2 shn0 = *(const f32x2*)(mb0 + kn), scn0 = *(const f32x2*)(mb0 + 1024 + kn), shn1 = *(const f32x2*)(mb1 + kn), scn1 = *(const f32x2*)(mb1 + 1024 + kn);
            const float a00 = xv0.x * rs0 * nw.x * (1.f + sc0.x) + sh0.x, a01 = xv0.y * rs0 * nw.y * (1.f + sc0.y) + sh0.y;
            const float a10 = xv1.x * rs1 * nw.x * (1.f + sc1.x) + sh1.x, a11 = xv1.y * rs1 * nw.y * (1.f + sc1.y) + sh1.y;
            *(unsigned*)(A1 + (size_t)row0 * 1024 + k) = pack2(a00, a01);
            if (has1) *(unsigned*)(A1 + (size_t)row1 * 1024 + k) = pack2(a10, a11);
#pragma unroll
            for (int j = 0; j < 16; ++j) { const f32x2 w = *(const LAS f32x2*)(wgT + j * 1024 + k); g0[j] += a00 * w.x + a01 * w.y; g1[j] += a10 * w.x + a11 * w.y; }
            xv0 = xn0; xv1 = xn1; nw = nwn; sh0 = shn0; sc0 = scn0; sh1 = shn1; sc1 = scn1; }
        float out0 = 0.f, out1 = 0.f;
#pragma unroll
        for (int j = 0; j < 16; ++j) { const float s0 = wsum(g0[j]), s1 = wsum(g1[j]); if (lane == j) { out0 = s0; out1 = s1; } }
        if (lane < 16) { gates[(size_t)row0 * 16 + lane] = out0 + a.gate_b[lane]; if (has1) gates[(size_t)row1 * 16 + lane] = out1 + a.gate_b[lane]; }
    }
}

__device__ void phase_n2(const Args& a) {
    const int tid = ltid(), lane = tid & 63, wave = tid >> 6;
    const float* mod = (const float*)(a.ws + WS_MOD);
    bf16_t* A2 = (bf16_t*)(a.ws + WS_A2);
    const int rstep = gridDim.x * 8;
    for (int row0 = lbid() * 8 + wave; row0 < NLAT; row0 += 2 * rstep) {
        f32x4 v[2][4]; float ss[2] = {0.f, 0.f};
#pragma unroll
        for (int q = 0; q < 2; ++q) { const int row = row0 + q * rstep; if (row < NLAT) { const float* src = a.out + (size_t)row * 1024;
#pragma unroll
            for (int i = 0; i < 4; ++i) v[q][i] = *(const f32x4*)(src + i * 256 + lane * 4); } }
#pragma unroll
        for (int q = 0; q < 2; ++q) { const int row = row0 + q * rstep; if (row < NLAT) {
#pragma unroll
            for (int i = 0; i < 4; ++i) ss[q] += v[q][i][0] * v[q][i][0] + v[q][i][1] * v[q][i][1] + v[q][i][2] * v[q][i][2] + v[q][i][3] * v[q][i][3]; } }
        ss[0] = wsum(ss[0]); ss[1] = wsum(ss[1]);
#pragma unroll
        for (int q = 0; q < 2; ++q) { const int row = row0 + q * rstep; if (row < NLAT) { const float rs = rsqrtf(ss[q] * (1.f / 1024.f) + 1e-6f); const float* mb = mod + (row >> 12) * 6144;
#pragma unroll
            for (int i = 0; i < 4; ++i) { const int k = i * 256 + lane * 4;
                const f32x4 nw = *(const f32x4*)(a.norm2_w + k), sh = *(const f32x4*)(mb + 3072 + k), sc = *(const f32x4*)(mb + 4096 + k);
                u32x2 w; w.x = pack2(v[q][i][0] * rs * nw[0] * (1.f + sc[0]) + sh[0], v[q][i][1] * rs * nw[1] * (1.f + sc[1]) + sh[1]);
                w.y = pack2(v[q][i][2] * rs * nw[2] * (1.f + sc[2]) + sh[2], v[q][i][3] * rs * nw[3] * (1.f + sc[3]) + sh[3]);
                *(u32x2*)(A2 + (size_t)row * 1024 + k) = w; } } }
    }
}
__device__ void phase_fn(const Args& a) {
    const int tid = ltid(), lane = tid & 63, wave = tid >> 6;
    const int rstep = gridDim.x * 8;
    f32x4 nw[4];
#pragma unroll
    for (int i = 0; i < 4; ++i) nw[i] = *(const f32x4*)(a.final_w + i * 256 + lane * 4);
    for (int row0 = lbid() * 8 + wave; row0 < NLAT; row0 += 2 * rstep) {
        f32x4 v[2][4]; float ss[2] = {0.f, 0.f};
#pragma unroll
        for (int q = 0; q < 2; ++q) { const int row = row0 + q * rstep; if (row < NLAT) { const float* src = a.out + (size_t)row * 1024;
#pragma unroll
            for (int i = 0; i < 4; ++i) v[q][i] = *(const f32x4*)(src + i * 256 + lane * 4); } }
#pragma unroll
        for (int q = 0; q < 2; ++q) { const int row = row0 + q * rstep; if (row < NLAT) {
#pragma unroll
            for (int i = 0; i < 4; ++i) ss[q] += v[q][i][0] * v[q][i][0] + v[q][i][1] * v[q][i][1] + v[q][i][2] * v[q][i][2] + v[q][i][3] * v[q][i][3]; } }
        ss[0] = wsum(ss[0]); ss[1] = wsum(ss[1]);
#pragma unroll
        for (int q = 0; q < 2; ++q) { const int row = row0 + q * rstep; if (row < NLAT) { const float rs = rsqrtf(ss[q] * (1.f / 1024.f) + 1e-6f); float* dst = a.out + (size_t)row * 1024;
#pragma unroll
            for (int i = 0; i < 4; ++i) *(f32x4*)(dst + i * 256 + lane * 4) = v[q][i] * rs * nw[i]; } }
    }
}

__device__ void phase_mc(const Args& a) {
    const int tid = ltid(), cgi = tid & 127, seg = tid >> 7, c0 = cgi * 8;
    const bf16_t* P = (const bf16_t*)(a.ws + WS_P); bf16_t* QK = (bf16_t*)(a.ws + WS_R1);
    float w[9][8];
#pragma unroll
    for (int t = 0; t < 9; ++t) { const f32x4 w0 = *(const f32x4*)(a.ml_conv_w + t * 1024 + c0), w1 = *(const f32x4*)(a.ml_conv_w + t * 1024 + c0 + 4);
        w[t][0] = w0[0]; w[t][1] = w0[1]; w[t][2] = w0[2]; w[t][3] = w0[3]; w[t][4] = w1[0]; w[t][5] = w1[1]; w[t][6] = w1[2]; w[t][7] = w1[3]; }
    const float qs = (c0 < 512) ? 0.08838834764831845f : 1.f;
    for (int it = lbid(); it < 640; it += gridDim.x) {
        int rowbase, W, H, y0, nrows, xb;
        if (it < 512) { const int b = it >> 6; rowbase = b * 4096; W = 64; H = 64; y0 = ((it >> 2) & 15) * 4; nrows = 4; xb = (it & 3) * 16; }
        else { const int ci = it - 512; rowbase = NLAT + (ci >> 4) * 256; W = 256; H = 1; y0 = 0; nrows = 1; xb = (ci & 15) * 16; }
        const int x0 = xb + seg * 4;
        u32x4 r[3][6];
        auto ldrow = [&](int y, u32x4 (&d)[6]) {
            const bool vy = (y >= 0 && y < H);
#pragma unroll
            for (int j = 0; j < 6; ++j) { const int xx = x0 - 1 + j;
                d[j] = (vy && xx >= 0 && xx < W) ? *(const u32x4*)(P + (size_t)(rowbase + y * W + xx) * NPC + c0) : (u32x4){0u, 0u, 0u, 0u}; } };
        ldrow(y0 - 1, r[0]); ldrow(y0, r[1]);
#pragma unroll 1
        for (int ry = 0; ry < nrows; ++ry) { const int y = y0 + ry;
            ldrow(y + 1, r[2]);
#pragma unroll
            for (int xi = 0; xi < 4; ++xi) {
                float acc[8];
#pragma unroll
                for (int e = 0; e < 8; ++e) acc[e] = 0.f;
#pragma unroll
                for (int dy = 0; dy < 3; ++dy)
#pragma unroll
                    for (int dx = 0; dx < 3; ++dx) { const u32x4 d = r[dy][xi + dx]; const int t = dy * 3 + dx;
                        acc[0] += lo_f(d.x) * w[t][0]; acc[1] += hi_f(d.x) * w[t][1]; acc[2] += lo_f(d.y) * w[t][2]; acc[3] += hi_f(d.y) * w[t][3];
                        acc[4] += lo_f(d.z) * w[t][4]; acc[5] += hi_f(d.z) * w[t][5]; acc[6] += lo_f(d.w) * w[t][6]; acc[7] += hi_f(d.w) * w[t][7]; }
                u32x4 o; o.x = pack2(silu(acc[0]) * qs, silu(acc[1]) * qs); o.y = pack2(silu(acc[2]) * qs, silu(acc[3]) * qs);
                o.z = pack2(silu(acc[4]) * qs, silu(acc[5]) * qs); o.w = pack2(silu(acc[6]) * qs, silu(acc[7]) * qs);
                *(u32x4*)(QK + (size_t)(rowbase + y * W + x0 + xi) * 1024 + c0) = o; }
#pragma unroll
            for (int j = 0; j < 6; ++j) { r[0][j] = r[1][j]; r[1][j] = r[2][j]; }
        }
    }
}

__device__ void phase_cv(const Args& a, int b_lo, bf16_t* ACT) {
    const int tid = ltid(), cgl = tid & 31, seg = tid >> 5;
    const bf16_t* U = (const bf16_t*)(a.ws + WS_U);
    for (int it = lbid(); it < 1408; it += gridDim.x) {
        const int cb = it % 22, band = (it / 22) & 15, bb = it / 352;
        const int c = cb * 128 + cgl * 4, y0 = band * 4, x0 = seg * 4;
        float wa[9][4], wb[9][4];
#pragma unroll
        for (int t = 0; t < 9; ++t) { const f32x4 w0 = *(const f32x4*)(a.ffn_conv_w + t * 5632 + c), w1 = *(const f32x4*)(a.ffn_conv_w + t * 5632 + 2816 + c);
            wa[t][0] = w0[0]; wa[t][1] = w0[1]; wa[t][2] = w0[2]; wa[t][3] = w0[3]; wb[t][0] = w1[0]; wb[t][1] = w1[1]; wb[t][2] = w1[2]; wb[t][3] = w1[3]; }
        const size_t rowb = (size_t)(b_lo + bb) * 4096;
        u32x2 ra[3][6], rbv[3][6];
        auto ldrow = [&](int y, u32x2 (&da)[6], u32x2 (&db)[6]) {
            const bool vy = (y >= 0 && y < 64);
#pragma unroll
            for (int j = 0; j < 6; ++j) { const int xx = x0 - 1 + j;
                if (vy && xx >= 0 && xx < 64) { const bf16_t* p = U + (rowb + y * 64 + xx) * 5632 + c; da[j] = *(const u32x2*)p; db[j] = *(const u32x2*)(p + 2816); }
                else { da[j] = (u32x2){0u, 0u}; db[j] = (u32x2){0u, 0u}; } } };
        ldrow(y0 - 1, ra[0], rbv[0]); ldrow(y0, ra[1], rbv[1]);
#pragma unroll
        for (int ry = 0; ry < 4; ++ry) { const int y = y0 + ry;
            ldrow(y + 1, ra[2], rbv[2]);
#pragma unroll
            for (int xi = 0; xi < 4; ++xi) {
                float aa[4] = {0.f, 0.f, 0.f, 0.f}, ab[4] = {0.f, 0.f, 0.f, 0.f};
#pragma unroll
                for (int dy = 0; dy < 3; ++dy)
#pragma unroll
                    for (int dx = 0; dx < 3; ++dx) { const int t = dy * 3 + dx; const u32x2 d = ra[dy][xi + dx], e = rbv[dy][xi + dx];
                        aa[0] += lo_f(d.x) * wa[t][0]; aa[1] += hi_f(d.x) * wa[t][1]; aa[2] += lo_f(d.y) * wa[t][2]; aa[3] += hi_f(d.y) * wa[t][3];
                        ab[0] += lo_f(e.x) * wb[t][0]; ab[1] += hi_f(e.x) * wb[t][1]; ab[2] += lo_f(e.y) * wb[t][2]; ab[3] += hi_f(e.y) * wb[t][3]; }
                u32x2 o; o.x = pack2(silu(aa[0]) * ab[0], silu(aa[1]) * ab[1]); o.y = pack2(silu(aa[2]) * ab[2], silu(aa[3]) * ab[3]);
                *(u32x2*)(ACT + ((size_t)bb * 4096 + y * 64 + x0 + xi) * 2816 + c) = o; }
#pragma unroll
            for (int j = 0; j < 6; ++j) { ra[0][j] = ra[1][j]; ra[1][j] = ra[2][j]; rbv[0][j] = rbv[1][j]; rbv[1][j] = rbv[2][j]; }
        }
    }
}

__device__ __forceinline__ void ml_scan(const LAS float* lf, const LAS float* ig, bool rev, int lane, float (&b)[4], float (&c)[4], float (&gm)[4], float& Btot, float& cmax) {
    float l[4], s = 0.f;
#pragma unroll
    for (int i = 0; i < 4; ++i) { const int p = 4 * lane + i, t = rev ? 255 - p : p; l[i] = lf[t]; s += l[i]; }
    const float incl = wscan_add(s, lane); float run = incl - s; Btot = __shfl(incl, 63);
    float cm = -INFINITY;
#pragma unroll
    for (int i = 0; i < 4; ++i) { const int p = 4 * lane + i, t = rev ? 255 - p : p; run += l[i]; b[i] = run; c[i] = ig[t] - run; cm = fmaxf(cm, c[i]); gm[i] = cm; }
    const float im = wscan_max(cm, lane); float ex = __shfl_up(im, 1); if (lane == 0) ex = -INFINITY;
#pragma unroll
    for (int i = 0; i < 4; ++i) gm[i] = fmaxf(gm[i], ex);
    cmax = __shfl(im, 63);
}

__device__ __forceinline__ void m1_matmul_store(const LAS unsigned char* vT, const LAS unsigned char* kT, bf16_t* dst, int wave, int lane) {
    const int r = lane & 15, kg = lane >> 4;
    f32x4 acc[8];
#pragma unroll
    for (int n = 0; n < 8; ++n) acc[n] = (f32x4){0.f, 0.f, 0.f, 0.f};
    const LAS unsigned char* pa = vT + (wave * 16 + r) * 528 + kg * 16;
    const LAS unsigned char* pb = kT + r * 528 + kg * 16;
#pragma unroll 2
    for (int ks = 0; ks < 8; ++ks) { const bf16x8 av = *(const LAS bf16x8*)(pa + ks * 64);
#pragma unroll
        for (int n = 0; n < 8; ++n) { const bf16x8 bv = *(const LAS bf16x8*)(pb + n * 16 * 528 + ks * 64); acc[n] = MFMA16(av, bv, acc[n]); } }
#pragma unroll
    for (int n = 0; n < 8; ++n)
#pragma unroll
        for (int j = 0; j < 4; ++j) dst[(wave * 16 + kg * 4 + j) * 128 + n * 16 + r] = f2bf(acc[n][j]);
}

__device__ __forceinline__ void load_vT256(const bf16_t* src, int ld, LAS unsigned char* vT, int tid) {
    const int s = tid & 255, half = tid >> 8;
    const bf16_t* p = src + (size_t)s * ld + half * 64;
#pragma unroll
    for (int q = 0; q < 8; ++q) { const u32x4 d = *(const u32x4*)(p + q * 8); const int cb = half * 64 + q * 8;
        LAS bf16_t* o = (LAS bf16_t*)vT + cb * 264 + s;
        o[0] = (bf16_t)(d.x & 0xffff); o[264] = (bf16_t)(d.x >> 16); o[2 * 264] = (bf16_t)(d.y & 0xffff); o[3 * 264] = (bf16_t)(d.y >> 16);
        o[4 * 264] = (bf16_t)(d.z & 0xffff); o[5 * 264] = (bf16_t)(d.z >> 16); o[6 * 264] = (bf16_t)(d.w & 0xffff); o[7 * 264] = (bf16_t)(d.w >> 16); }
}

constexpr int M1_VT = 0, M1_KT = 67584, M1_MISC = 135168;
__device__ void m1_hg_item(const Args& a, LAS unsigned char* lds, int rowbase, int h, int seqF, int slotF, int slotB);

__device__ void phase_m1(const Args& a, LAS unsigned char* lds) {
    const int tid = ltid(), lane = tid & 63, wave = tid >> 6;
    const bf16_t* P = (const bf16_t*)(a.ws + WS_P); const bf16_t* QK = (const bf16_t*)(a.ws + WS_R1);
    const float* gates = (const float*)(a.ws + WS_GATES);
    bf16_t* mlst = (bf16_t*)a.out; bf16_t* hgst = (bf16_t*)a.out + (size_t)1024 * 16384;
    float* ml_n = (float*)(a.ws + WS_SMALL + SM_MLN); float* hg_B = (float*)(a.ws + WS_SMALL + SM_HGB);
    float* ml_mloc = (float*)(a.ws + WS_SMALL + SM_MLOC); float* ml_B = (float*)(a.ws + WS_SMALL + SM_MLB);
    LAS unsigned char* vT = lds + M1_VT; LAS unsigned char* kT = lds + M1_KT;
    LAS float* misc = (LAS float*)(lds + M1_MISC);
    LAS float *lfF = misc, *igF = misc + 256, *lfB = misc + 512, *igB = misc + 768, *wF = misc + 1024, *wB = misc + 1280, *scal = misc + 1536, *nred = misc + 1552;
    const int nblk = gridDim.x, bidx = lbid(); const int nheavy3 = (nblk == 256) ? 64 : 0;
    for (int pass = 0; pass < 2; ++pass) {
      const bool isml = pass == 1; const int qstart = isml ? bidx - nheavy3 : bidx, qstride = isml ? nblk - nheavy3 : nblk, qend = isml ? 544 : 1088;
      if (qstart < 0) continue;
      for (int qq = qstart; qq < qend; qq += qstride) {
        const int q = isml ? qq : (qq >> 1); const int hdir = qq & 1;
        const int b = q / 68, h = (q / 17) & 3, sc = q % 17;
        const int rowbase = sc == 0 ? NLAT + b * 256 : b * 4096 + (sc - 1) * 256;
        int slotF = sc <= 15 ? sc : -1, slotB = sc == 0 ? 0 : (sc >= 2 ? 17 - sc : -1);
        if (!isml) { if (hdir) slotF = -1; else slotB = -1; if (slotF < 0 && slotB < 0) continue; }
        const int seqF = (b * 4 + h) * 2, seqB = seqF + 1;
        __syncthreads();
        if (isml) {
            if (tid < 256) { const float* g = gates + (size_t)(rowbase + tid) * 16; igF[tid] = g[h]; lfF[tid] = logsig(g[4 + h]); igB[tid] = g[8 + h]; lfB[tid] = logsig(g[12 + h]); }
            load_vT256(P + (size_t)rowbase * NPC + 1024 + h * 128, NPC, vT, tid);
            __syncthreads();
            if (wave < 2) { float bb[4], cc[4], gm[4], Bt, cmx; const bool rev = wave == 1;
                ml_scan(rev ? lfB : lfF, rev ? igB : igF, rev, lane, bb, cc, gm, Bt, cmx);
                LAS float* wd = rev ? wB : wF;
#pragma unroll
                for (int i = 0; i < 4; ++i) { const int p = 4 * lane + i, t = rev ? 255 - p : p; wd[t] = __expf(cc[i] - cmx); }
                if (lane == 0) { scal[wave * 2] = Bt + cmx; scal[wave * 2 + 1] = Bt; } }
            const int s = tid & 255, half = tid >> 8;
            u32x4 kr[8];
            { const bf16_t* p = QK + (size_t)(rowbase + s) * 1024 + 512 + h * 128 + half * 64;
#pragma unroll
              for (int qq = 0; qq < 8; ++qq) kr[qq] = *(const u32x4*)(p + qq * 8); }
            __syncthreads();
#pragma unroll
            for (int dir = 0; dir < 2; ++dir) {
                const int slot = dir ? slotB : slotF; const int seq = dir ? seqB : seqF;
                if (slot >= 0) {
                    const float wv = dir ? wB[s] : wF[s];
#pragma unroll
                    for (int qq = 0; qq < 8; ++qq) { const u32x4 d = kr[qq]; LAS bf16_t* o = (LAS bf16_t*)kT + (half * 64 + qq * 8) * 264 + s;
                        o[0] = f2bf(lo_f(d.x) * wv); o[264] = f2bf(hi_f(d.x) * wv); o[2 * 264] = f2bf(lo_f(d.y) * wv); o[3 * 264] = f2bf(hi_f(d.y) * wv);
                        o[4 * 264] = f2bf(lo_f(d.z) * wv); o[5 * 264] = f2bf(hi_f(d.z) * wv); o[6 * 264] = f2bf(lo_f(d.w) * wv); o[7 * 264] = f2bf(hi_f(d.w) * wv); }
                    __syncthreads();
                    m1_matmul_store(vT, kT, mlst + (size_t)(seq * 16 + slot) * 16384, wave, lane);
                    { const int dk = tid & 127, part = tid >> 7; float sm = 0.f; const LAS bf16_t* kp = (const LAS bf16_t*)kT + dk * 264 + part * 64;
                      for (int e = 0; e < 64; ++e) sm += bf2f(kp[e]);
                      nred[part * 128 + dk] = sm; }
                    __syncthreads();
                    if (tid < 128) ml_n[(size_t)(seq * 16 + slot) * 128 + tid] = nred[tid] + nred[128 + tid] + nred[256 + tid] + nred[384 + tid];
                    if (tid == 0) { ml_mloc[seq * 16 + slot] = scal[dir * 2]; ml_B[seq * 16 + slot] = scal[dir * 2 + 1]; }
                }
            }
        } else {
            m1_hg_item(a, lds, rowbase, h, seqF, slotF, slotB);
        }
    }
  }
}

__device__ void phase_m2(const Args& a) {
    bf16_t* mlst = (bf16_t*)a.out; bf16_t* hgst = (bf16_t*)a.out + (size_t)1024 * 16384;
    float* ml_n = (float*)(a.ws + WS_SMALL + SM_MLN); const float* hg_B = (const float*)(a.ws + WS_SMALL + SM_HGB);
    const float* ml_mloc = (const float*)(a.ws + WS_SMALL + SM_MLOC); const float* ml_B = (const float*)(a.ws + WS_SMALL + SM_MLB); float* ml_mpre = (float*)(a.ws + WS_SMALL + SM_MPRE);
    const int gtid = lbid() * NT + ltid(), gn = gridDim.x * NT;
    for (int g = gtid; g < 64 * 2048; g += gn) {
        const int seq = g >> 11, ch = g & 2047;
        bf16_t* base = mlst + (size_t)seq * 16 * 16384 + ch * 8;
        float m = ml_mloc[seq * 16]; float C[8];
        { const u32x4 d = *(const u32x4*)base; C[0] = lo_f(d.x); C[1] = hi_f(d.x); C[2] = lo_f(d.y); C[3] = hi_f(d.y); C[4] = lo_f(d.z); C[5] = hi_f(d.z); C[6] = lo_f(d.w); C[7] = hi_f(d.w); }
        if (ch == 0) ml_mpre[seq * 16] = m;
        u32x4 dnx = *(const u32x4*)(base + (size_t)16384);
        for (int p = 1; p < 16; ++p) { const float ml = ml_mloc[seq * 16 + p], B = ml_B[seq * 16 + p]; const float mn = fmaxf(B + m, ml); const float fa = __expf(B + m - mn), fb = __expf(ml - mn);
            const u32x4 d = dnx; if (p < 15) dnx = *(const u32x4*)(base + (size_t)(p + 1) * 16384);
            C[0] = fa * C[0] + fb * lo_f(d.x); C[1] = fa * C[1] + fb * hi_f(d.x); C[2] = fa * C[2] + fb * lo_f(d.y); C[3] = fa * C[3] + fb * hi_f(d.y);
            C[4] = fa * C[4] + fb * lo_f(d.z); C[5] = fa * C[5] + fb * hi_f(d.z); C[6] = fa * C[6] + fb * lo_f(d.w); C[7] = fa * C[7] + fb * hi_f(d.w);
            u32x4 o; o.x = pack2(C[0], C[1]); o.y = pack2(C[2], C[3]); o.z = pack2(C[4], C[5]); o.w = pack2(C[6], C[7]);
            *(u32x4*)(base + (size_t)p * 16384) = o; m = mn; if (ch == 0) ml_mpre[seq * 16 + p] = m; }
    }
    for (int g = gtid; g < 64 * 128; g += gn) {
        const int seq = g >> 7, dk = g & 127; float* base = ml_n + (size_t)seq * 16 * 128 + dk;
        float m = ml_mloc[seq * 16], n = base[0];
        for (int p = 1; p < 16; ++p) { const float ml = ml_mloc[seq * 16 + p], B = ml_B[seq * 16 + p]; const float mn = fmaxf(B + m, ml);
            n = __expf(B + m - mn) * n + __expf(ml - mn) * base[p * 128]; base[p * 128] = n; m = mn; }
    }
    for (int g = gtid; g < 64 * 2048; g += gn) {
        const int seq = g >> 11, ch = g & 2047, dk0 = (ch * 8) & 127;
        bf16_t* base = hgst + (size_t)seq * 16 * 16384 + ch * 8;
        float C[8];
        { const u32x4 d = *(const u32x4*)base; C[0] = lo_f(d.x); C[1] = hi_f(d.x); C[2] = lo_f(d.y); C[3] = hi_f(d.y); C[4] = lo_f(d.z); C[5] = hi_f(d.z); C[6] = lo_f(d.w); C[7] = hi_f(d.w); }
        u32x4 dnx = *(const u32x4*)(base + (size_t)16384);
        for (int p = 1; p < 16; ++p) { const float* bp = hg_B + (size_t)(seq * 16 + p) * 128 + dk0; const f32x4 b0 = *(const f32x4*)bp, b1 = *(const f32x4*)(bp + 4);
            const u32x4 d = dnx; if (p < 15) dnx = *(const u32x4*)(base + (size_t)(p + 1) * 16384);
            C[0] = __expf(b0[0]) * C[0] + lo_f(d.x); C[1] = __expf(b0[1]) * C[1] + hi_f(d.x); C[2] = __expf(b0[2]) * C[2] + lo_f(d.y); C[3] = __expf(b0[3]) * C[3] + hi_f(d.y);
            C[4] = __expf(b1[0]) * C[4] + lo_f(d.z); C[5] = __expf(b1[1]) * C[5] + hi_f(d.z); C[6] = __expf(b1[2]) * C[6] + lo_f(d.w); C[7] = __expf(b1[3]) * C[7] + hi_f(d.w);
            u32x4 o; o.x = pack2(C[0], C[1]); o.y = pack2(C[2], C[3]); o.z = pack2(C[4], C[5]); o.w = pack2(C[6], C[7]);
            *(u32x4*)(base + (size_t)p * 16384) = o; }
    }
}

constexpr int HG_Q1 = 0, HG_K1 = 17408, HG_KST = 34816, HG_VT = 53248, HG_PB = 71680, HG_ST = 80896, HG_MISC = 115712;

struct StageRegs { u32x4 a0, a1, b0, b1, v0, v1; float g0, g1; };
template <int DIR, bool OUT>
__device__ __forceinline__ void hg_fetch(const Args& a, int rb, int h, StageRegs& R) {
    const int tid = ltid(); const bf16_t* P = (const bf16_t*)(a.ws + WS_P);
    const int s = tid >> 3, sg8 = tid & 7; const bf16_t* rp = P + (size_t)(rb + s) * NPC + h * 128 + sg8 * 16;
    R.a0 = *(const u32x4*)(rp + 2560 + DIR * 512); R.a1 = *(const u32x4*)(rp + 2560 + DIR * 512 + 8);
    if (OUT) { R.b0 = *(const u32x4*)(rp + 2048); R.b1 = *(const u32x4*)(rp + 2048 + 8); }
    const int s2 = tid & 63, cp = tid >> 6; const bf16_t* vp = P + (size_t)(rb + s2) * NPC + 3584 + h * 128 + cp * 16;
    R.v0 = *(const u32x4*)vp; R.v1 = *(const u32x4*)(vp + 8);
}
__device__ __forceinline__ void stage_vT64(LAS unsigned char* lds, int tid, const u32x4& d0, const u32x4& d1) {
    const int s2 = tid & 63, cp = tid >> 6;
#pragma unroll
    for (int qq = 0; qq < 2; ++qq) { const u32x4 d = qq ? d1 : d0; LAS bf16_t* o = (LAS bf16_t*)(lds + HG_VT) + (cp * 16 + qq * 8) * 72 + s2;
        o[0] = (bf16_t)(d.x & 0xffff); o[72] = (bf16_t)(d.x >> 16); o[2 * 72] = (bf16_t)(d.y & 0xffff); o[3 * 72] = (bf16_t)(d.y >> 16);
        o[4 * 72] = (bf16_t)(d.z & 0xffff); o[5 * 72] = (bf16_t)(d.z >> 16); o[6 * 72] = (bf16_t)(d.w & 0xffff); o[7 * 72] = (bf16_t)(d.w >> 16); }
}
template <int DIR, bool OUT>
__device__ __forceinline__ void hg_sub(const Args& a, LAS unsigned char* lds, int rbn, int h, float lb, f32x4 (&st)[8], f32x4 (&oacc)[4], float& bLsum, StageRegs& R) {
    int tid = ltid();
    const int lane = tid & 63, wave = tid >> 6, r = lane & 15, kg = lane >> 4;
    LAS float* misc = (LAS float*)(lds + HG_MISC); LAS float* psum = misc; LAS float* eBL = misc + 512;
    { const int s = tid >> 3, sg8 = tid & 7;
      *(LAS u32x4*)(lds + HG_K1 + s * 272 + sg8 * 32) = R.a0; *(LAS u32x4*)(lds + HG_K1 + s * 272 + sg8 * 32 + 16) = R.a1;
      if (OUT) { *(LAS u32x4*)(lds + HG_Q1 + s * 272 + sg8 * 32) = R.b0; *(LAS u32x4*)(lds + HG_Q1 + s * 272 + sg8 * 32 + 16) = R.b1; }
      stage_vT64(lds, tid, R.v0, R.v1);
      if (rbn >= 0) hg_fetch<DIR, OUT>(a, rbn, h, R); }
    __syncthreads();
    { const int c = tid & 127, part = tid >> 7;
      float sm = 0.f; float sgv[16], lfv[16];
#pragma unroll
      for (int i = 0; i < 16; ++i) { const int u = part * 16 + i, t = DIR ? 63 - u : u; const float z = bf2f(((const LAS bf16_t*)(lds + HG_K1))[t * 136 + c]); sgv[i] = sigm(z); lfv[i] = __logf(lb + (1.f - lb) * sgv[i]); sm += lfv[i]; }
      psum[part * 128 + c] = sm;
      __syncthreads();
      const float p0 = psum[c], p1 = psum[128 + c], p2 = psum[256 + c], p3 = psum[384 + c];
      const float ref = p0 + p1, bL = p0 + p1 + p2 + p3;
      float run = part == 0 ? 0.f : (part == 1 ? p0 : (part == 2 ? p0 + p1 : p0 + p1 + p2));
      if (part == 0) eBL[c] = __expf(bL);
      bLsum += bL;
      const float ebr = __expf(bL - ref);
#pragma unroll
      for (int i = 0; i < 16; ++i) { const int u = part * 16 + i, t = DIR ? 63 - u : u;
          run += lfv[i]; const float kk = (1.f - lb) * (1.f - sgv[i]);
          if (OUT) { const float qv = bf2f(((const LAS bf16_t*)(lds + HG_Q1))[t * 136 + c]);
              const float er = __expf(run - ref); const float kr = kk * __builtin_amdgcn_rcpf(er);
              ((LAS bf16_t*)(lds + HG_Q1))[t * 136 + c] = f2bf(qv * er);
              ((LAS bf16_t*)(lds + HG_K1))[t * 136 + c] = f2bf(kr);
              ((LAS bf16_t*)(lds + HG_KST))[c * 72 + t] = f2bf(kr * ebr); }
          else ((LAS bf16_t*)(lds + HG_KST))[c * 72 + t] = f2bf(kk * __expf(bL - run)); }
      if (OUT) {
#pragma unroll
          for (int n = 0; n < 8; ++n) { const int dk = n * 16 + r; const float e = __expf(psum[dk] + psum[128 + dk]);
#pragma unroll
              for (int jj = 0; jj < 4; ++jj) ((LAS bf16_t*)(lds + HG_ST))[(wave * 16 + kg * 4 + jj) * 136 + dk] = f2bf(st[n][jj] * e); } }
    }
    __syncthreads();
    if (OUT) {
        { const int mt = wave >> 1, n0 = (wave & 1) * 2;
          f32x4 s0 = (f32x4){0.f, 0.f, 0.f, 0.f}, s1 = s0;
#pragma unroll
          for (int ks = 0; ks < 4; ++ks) { const bf16x8 av = *(const LAS bf16x8*)(lds + HG_Q1 + (mt * 16 + r) * 272 + ks * 64 + kg * 16);
              const bf16x8 b0 = *(const LAS bf16x8*)(lds + HG_K1 + (n0 * 16 + r) * 272 + ks * 64 + kg * 16), b1 = *(const LAS bf16x8*)(lds + HG_K1 + ((n0 + 1) * 16 + r) * 272 + ks * 64 + kg * 16);
              s0 = MFMA16(av, b0, s0); s1 = MFMA16(av, b1, s1); }
#pragma unroll
          for (int jj = 0; jj < 4; ++jj) { const int t = mt * 16 + kg * 4 + jj; const int sA = n0 * 16 + r, sB = (n0 + 1) * 16 + r;
              const bool kA = DIR ? (sA >= t) : (sA <= t), kB = DIR ? (sB >= t) : (sB <= t);
              ((LAS bf16_t*)(lds + HG_PB))[t * 72 + sA] = kA ? f2bf(s0[jj]) : (bf16_t)0; ((LAS bf16_t*)(lds + HG_PB))[t * 72 + sB] = kB ? f2bf(s1[jj]) : (bf16_t)0; } }
        __syncthreads();
        { const int mt = wave >> 1, nv0 = (wave & 1) * 4;
#pragma unroll
          for (int ks2 = 0; ks2 < 2; ++ks2) { const bf16x8 av = *(const LAS bf16x8*)(lds + HG_PB + (mt * 16 + r) * 144 + ks2 * 64 + kg * 16);
#pragma unroll
              for (int i = 0; i < 4; ++i) { const bf16x8 bv = *(const LAS bf16x8*)(lds + HG_VT + ((nv0 + i) * 16 + r) * 144 + ks2 * 64 + kg * 16); oacc[i] = MFMA16(av, bv, oacc[i]); } }
#pragma unroll
          for (int ks = 0; ks < 4; ++ks) { const bf16x8 av = *(const LAS bf16x8*)(lds + HG_Q1 + (mt * 16 + r) * 272 + ks * 64 + kg * 16);
#pragma unroll
              for (int i = 0; i < 4; ++i) { const bf16x8 bv = *(const LAS bf16x8*)(lds + HG_ST + ((nv0 + i) * 16 + r) * 272 + ks * 64 + kg * 16); oacc[i] = MFMA16(av, bv, oacc[i]); } } }
    }
#pragma unroll
    for (int n = 0; n < 8; ++n) { const float e = eBL[n * 16 + r]; st[n] = st[n] * e; }
#pragma unroll
    for (int ks2 = 0; ks2 < 2; ++ks2) { const bf16x8 av = *(const LAS bf16x8*)(lds + HG_VT + (wave * 16 + r) * 144 + ks2 * 64 + kg * 16);
#pragma unroll
        for (int n = 0; n < 8; ++n) { const bf16x8 bv = *(const LAS bf16x8*)(lds + HG_KST + (n * 16 + r) * 144 + ks2 * 64 + kg * 16); st[n] = MFMA16(av, bv, st[n]); } }
    __syncthreads();
}

__device__ __forceinline__ float hg_lb(const Args& a, int dir, int h, int c) {
    const float l0 = a.lb_logits[(dir * 2 + 0) * 512 + h * 128 + c], l1 = a.lb_logits[(dir * 2 + 1) * 512 + h * 128 + c]; return __builtin_amdgcn_rcpf(1.f + __expf(l1 - l0)); }

__device__ void m1_hg_item(const Args& a, LAS unsigned char* lds, int rowbase, int h, int seqF, int slotF, int slotB) {
    const int tid = ltid(), lane = tid & 63, wave = tid >> 6, r = lane & 15, kg = lane >> 4, c = tid & 127;
    bf16_t* hgst = (bf16_t*)a.out + (size_t)1024 * 16384; float* hg_B = (float*)(a.ws + WS_SMALL + SM_HGB);
    f32x4 dummy[4]; f32x4 st[8]; StageRegs R;
    __syncthreads();
    if (slotF >= 0) {
        const float lb = hg_lb(a, 0, h, c); float bs = 0.f;
#pragma unroll
        for (int n = 0; n < 8; ++n) st[n] = (f32x4){0.f, 0.f, 0.f, 0.f};
        hg_fetch<0, false>(a, rowbase, h, R);
#pragma unroll 1
        for (int scu = 0; scu < 4; ++scu) hg_sub<0, false>(a, lds, scu < 3 ? rowbase + (scu + 1) * 64 : -1, h, lb, st, dummy, bs, R);
        bf16_t* dst = hgst + (size_t)(seqF * 16 + slotF) * 16384;
#pragma unroll
        for (int n = 0; n < 8; ++n)
#pragma unroll
            for (int jj = 0; jj < 4; ++jj) dst[(wave * 16 + kg * 4 + jj) * 128 + n * 16 + r] = f2bf(st[n][jj]);
        if (tid < 128) hg_B[(size_t)(seqF * 16 + slotF) * 128 + c] = bs;
    }
    if (slotB >= 0) {
        const float lb = hg_lb(a, 1, h, c); float bs = 0.f;
#pragma unroll
        for (int n = 0; n < 8; ++n) st[n] = (f32x4){0.f, 0.f, 0.f, 0.f};
        hg_fetch<1, false>(a, rowbase + 192, h, R);
#pragma unroll 1
        for (int scu = 0; scu < 4; ++scu) hg_sub<1, false>(a, lds, scu < 3 ? rowbase + (2 - scu) * 64 : -1, h, lb, st, dummy, bs, R);
        bf16_t* dst = hgst + (size_t)((seqF + 1) * 16 + slotB) * 16384;
#pragma unroll
        for (int n = 0; n < 8; ++n)
#pragma unroll
            for (int jj = 0; jj < 4; ++jj) dst[(wave * 16 + kg * 4 + jj) * 128 + n * 16 + r] = f2bf(st[n][jj]);
        if (tid < 128) hg_B[(size_t)((seqF + 1) * 16 + slotB) * 128 + c] = bs;
    }
}

__device__ void m3_hg_item(const Args& a, LAS unsigned char* lds, int q) {
    const int tid = ltid(), lane = tid & 63, wave = tid >> 6, r = lane & 15, kg = lane >> 4;
    const int b = q >> 6, h = (q >> 4) & 3, j = (q & 15) + 1;
    const int rowbase = b * 4096 + (j - 1) * 256;
    const bf16_t* P = (const bf16_t*)(a.ws + WS_P);
    const bf16_t* hgst = (const bf16_t*)a.out + (size_t)1024 * 16384;
    bf16_t* Y = (bf16_t*)(a.ws + WS_Y);
    const int seqF = (b * 4 + h) * 2, seqB = seqF + 1;
    const int slF = seqF * 16 + (j - 1), slB = seqB * 16 + (16 - j);
    const int c = tid & 127;
    const int mt = wave >> 1, hv = wave & 1;
    f32x4 st[8]; float bs = 0.f; StageRegs R;
    __syncthreads();
    {
        const float lb = hg_lb(a, 0, h, c);
        hg_fetch<0, true>(a, rowbase, h, R);
        const bf16_t* sp = hgst + (size_t)slF * 16384;
#pragma unroll
        for (int n = 0; n < 8; ++n)
#pragma unroll
            for (int jj = 0; jj < 4; ++jj) st[n][jj] = bf2f(sp[(wave * 16 + kg * 4 + jj) * 128 + n * 16 + r]);
#pragma unroll 1
        for (int scu = 0; scu < 4; ++scu) {
            f32x4 o[4];
#pragma unroll
            for (int i = 0; i < 4; ++i) o[i] = (f32x4){0.f, 0.f, 0.f, 0.f};
            const int rb = rowbase + scu * 64;
            hg_sub<0, true>(a, lds, scu < 3 ? rb + 64 : -1, h, lb, st, o, bs, R);
            { u32x4* pk = (u32x4*)(a.ws + WS_PARK + (size_t)lbid() * 65536) + (scu * NT + tid) * 2;
              pk[0] = (u32x4){pack2(o[0][0], o[0][1]), pack2(o[0][2], o[0][3]), pack2(o[1][0], o[1][1]), pack2(o[1][2], o[1][3])};
              pk[1] = (u32x4){pack2(o[2][0], o[2][1]), pack2(o[2][2], o[2][3]), pack2(o[3][0], o[3][1]), pack2(o[3][2], o[3][3])}; }
        }
    }
    {
        const float lb = hg_lb(a, 1, h, c);
        hg_fetch<1, true>(a, rowbase + 192, h, R);
        const bf16_t* sp = hgst + (size_t)slB * 16384;
        LAS float* ssq = (LAS float*)(lds + HG_MISC) + 1024;
#pragma unroll
        for (int n = 0; n < 8; ++n)
#pragma unroll
            for (int jj = 0; jj < 4; ++jj) st[n][jj] = bf2f(sp[(wave * 16 + kg * 4 + jj) * 128 + n * 16 + r]);
#pragma unroll 1
        for (int scu = 0; scu < 4; ++scu) {
            f32x4 o[4];
#pragma unroll
            for (int i = 0; i < 4; ++i) o[i] = (f32x4){0.f, 0.f, 0.f, 0.f};
            const int rb = rowbase + (3 - scu) * 64;
            hg_sub<1, true>(a, lds, scu < 3 ? rb - 64 : -1, h, lb, st, o, bs, R);
            const u32x4* pkp = (const u32x4*)(a.ws + WS_PARK + (size_t)lbid() * 65536) + ((3 - scu) * NT + tid) * 2; const u32x4 pk0 = pkp[0], pk1 = pkp[1];
#pragma unroll
            for (int jj = 0; jj < 4; ++jj) { float ss = 0.f;
#pragma unroll
                for (int i = 0; i < 4; ++i) { const unsigned pw = (i < 2 ? pk0 : pk1)[(i & 1) * 2 + (jj >> 1)]; const float v = o[i][jj] + ((jj & 1) ? hi_f(pw) : lo_f(pw)); o[i][jj] = v; ss += v * v; }
                ss = red16(ss); if (r == 0) ssq[(mt * 16 + kg * 4 + jj) * 2 + hv] = ss; }
            __syncthreads();
#pragma unroll
            for (int jj = 0; jj < 4; ++jj) { const int t = mt * 16 + kg * 4 + jj; const float rs = rsqrtf((ssq[t * 2] + ssq[t * 2 + 1]) * (1.f / 128.f) + 1e-6f);
#pragma unroll
                for (int i = 0; i < 4; ++i) { const int col = h * 128 + hv * 64 + i * 16 + r; const float g = bf2f(P[(size_t)(rb + t) * NPC + 4096 + col]);
                    Y[(size_t)(rb + t) * 1024 + 512 + col] = f2bf(o[i][jj] * rs * a.hg_norm_w[col] * g); } }
        }
    }
}

template <int DIR>
__device__ __forceinline__ void ml_fetch(const Args& a, int rb, int h, StageRegs& R) {
    const int tid = ltid(); const bf16_t* P = (const bf16_t*)(a.ws + WS_P); const bf16_t* QK = (const bf16_t*)(a.ws + WS_R1); const float* gates = (const float*)(a.ws + WS_GATES);
    const int s = tid >> 3, sg8 = tid & 7; const bf16_t* qp = QK + (size_t)(rb + s) * 1024 + h * 128 + sg8 * 16;
    R.b0 = *(const u32x4*)qp; R.b1 = *(const u32x4*)(qp + 8); R.a0 = *(const u32x4*)(qp + 512); R.a1 = *(const u32x4*)(qp + 520);
    const int s2 = tid & 63, cp = tid >> 6; const bf16_t* vp = P + (size_t)(rb + s2) * NPC + 1024 + h * 128 + cp * 16;
    R.v0 = *(const u32x4*)vp; R.v1 = *(const u32x4*)(vp + 8);
}
template <int DIR>
__device__ __forceinline__ void ml_sub(const Args& a, LAS unsigned char* lds, int rbn, int scp, int h, f32x4 (&st)[8], f32x4 (&hout)[4], StageRegs& R) {
    const int tid = ltid(), lane = tid & 63, wave = tid >> 6, r = lane & 15, kg = lane >> 4;
    LAS float* mf = (LAS float*)(lds + HG_MISC);
    LAS float *psum = mf, *nS = mf + 512, *scal = mf + 1088, *denP = mf + 1104, *qnP = mf + 1232;
    const LAS float *cL = mf + 1872 + scp * 64, *gL = mf + 2128 + scp * 64, *bLc = mf + 2384 + scp * 64; const LAS float *BtotA = mf + 2640, *cmaxA = mf + 2644;
    { const int s = tid >> 3, sg8 = tid & 7;
      *(LAS u32x4*)(lds + HG_Q1 + s * 272 + sg8 * 32) = R.b0; *(LAS u32x4*)(lds + HG_Q1 + s * 272 + sg8 * 32 + 16) = R.b1;
      *(LAS u32x4*)(lds + HG_K1 + s * 272 + sg8 * 32) = R.a0; *(LAS u32x4*)(lds + HG_K1 + s * 272 + sg8 * 32 + 16) = R.a1;
      stage_vT64(lds, tid, R.v0, R.v1);
      if (rbn >= 0) ml_fetch<DIR>(a, rbn, h, R); }
    __syncthreads();
    const float mprev = scal[1]; const float Mall = fmaxf(mprev, cmaxA[scp]);
    { const int mt = wave >> 1, n0 = (wave & 1) * 2;
      f32x4 s0 = (f32x4){0.f, 0.f, 0.f, 0.f}, s1 = s0;
#pragma unroll
      for (int ks = 0; ks < 4; ++ks) { const bf16x8 av = *(const LAS bf16x8*)(lds + HG_Q1 + (mt * 16 + r) * 272 + ks * 64 + kg * 16);
          const bf16x8 b0 = *(const LAS bf16x8*)(lds + HG_K1 + (n0 * 16 + r) * 272 + ks * 64 + kg * 16), b1 = *(const LAS bf16x8*)(lds + HG_K1 + ((n0 + 1) * 16 + r) * 272 + ks * 64 + kg * 16);
          s0 = MFMA16(av, b0, s0); s1 = MFMA16(av, b1, s1); }
      const int sA = n0 * 16 + r, sB = sA + 16; const float cAv = cL[sA], cBv = cL[sB];
#pragma unroll
      for (int jj = 0; jj < 4; ++jj) { const int t = mt * 16 + kg * 4 + jj; const float Mt = fmaxf(mprev, gL[t]);
          const bool kA = DIR ? (sA >= t) : (sA <= t), kB = DIR ? (sB >= t) : (sB <= t);
          const float pA = kA ? s0[jj] * __expf(cAv - Mt) : 0.f, pB = kB ? s1[jj] * __expf(cBv - Mt) : 0.f;
          ((LAS bf16_t*)(lds + HG_PB))[t * 72 + sA] = f2bf(pA); ((LAS bf16_t*)(lds + HG_PB))[t * 72 + sB] = f2bf(pB);
          const float ds = red16(pA + pB); if (r == 0) denP[t * 2 + (wave & 1)] = ds; } }
    { const int c = tid & 127, part = tid >> 7; float sm = 0.f;
#pragma unroll 4
      for (int i = 0; i < 16; ++i) { const int t = part * 16 + i; const float kw = bf2f(((const LAS bf16_t*)(lds + HG_K1))[t * 136 + c]) * __expf(cL[t] - Mall);
          ((LAS bf16_t*)(lds + HG_KST))[c * 72 + t] = f2bf(kw); sm += kw; }
      psum[part * 128 + c] = sm; }
    { const int t = tid & 63, p8 = tid >> 6; float acc = 0.f;
#pragma unroll 4
      for (int i = 0; i < 16; ++i) { const int dk = p8 * 16 + i; acc += bf2f(((const LAS bf16_t*)(lds + HG_Q1))[t * 136 + dk]) * nS[dk]; }
      qnP[p8 * 64 + t] = acc; }
#pragma unroll
    for (int n = 0; n < 8; ++n)
#pragma unroll
        for (int jj = 0; jj < 4; ++jj) ((LAS bf16_t*)(lds + HG_ST))[(wave * 16 + kg * 4 + jj) * 136 + n * 16 + r] = f2bf(st[n][jj]);
    __syncthreads();
    { const int mt = wave >> 1, nv0 = (wave & 1) * 4;
      f32x4 o1[4], o2[4];
#pragma unroll
      for (int i = 0; i < 4; ++i) { o1[i] = (f32x4){0.f, 0.f, 0.f, 0.f}; o2[i] = o1[i]; }
#pragma unroll
      for (int ks2 = 0; ks2 < 2; ++ks2) { const bf16x8 av = *(const LAS bf16x8*)(lds + HG_PB + (mt * 16 + r) * 144 + ks2 * 64 + kg * 16);
#pragma unroll
          for (int i = 0; i < 4; ++i) { const bf16x8 bv = *(const LAS bf16x8*)(lds + HG_VT + ((nv0 + i) * 16 + r) * 144 + ks2 * 64 + kg * 16); o1[i] = MFMA16(av, bv, o1[i]); } }
#pragma unroll
      for (int ks = 0; ks < 4; ++ks) { const bf16x8 av = *(const LAS bf16x8*)(lds + HG_Q1 + (mt * 16 + r) * 272 + ks * 64 + kg * 16);
#pragma unroll
          for (int i = 0; i < 4; ++i) { const bf16x8 bv = *(const LAS bf16x8*)(lds + HG_ST + ((nv0 + i) * 16 + r) * 272 + ks * 64 + kg * 16); o2[i] = MFMA16(av, bv, o2[i]); } }
#pragma unroll
      for (int jj = 0; jj < 4; ++jj) { const int t = mt * 16 + kg * 4 + jj; const float Mt = fmaxf(mprev, gL[t]); const float wi = __expf(mprev - Mt);
          float qn = 0.f;
#pragma unroll
          for (int p8 = 0; p8 < 8; ++p8) qn += qnP[p8 * 64 + t];
          const float den = denP[t * 2] + denP[t * 2 + 1] + wi * qn; const float inv = __builtin_amdgcn_rcpf(fmaxf(fabsf(den), __expf(-bLc[t] - Mt)));
#pragma unroll
          for (int i = 0; i < 4; ++i) hout[i][jj] = (o1[i][jj] + wi * o2[i][jj]) * inv; } }
    const float decay = __expf(mprev - Mall);
#pragma unroll
    for (int n = 0; n < 8; ++n) st[n] = st[n] * decay;
#pragma unroll
    for (int ks2 = 0; ks2 < 2; ++ks2) { const bf16x8 av = *(const LAS bf16x8*)(lds + HG_VT + (wave * 16 + r) * 144 + ks2 * 64 + kg * 16);
#pragma unroll
        for (int n = 0; n < 8; ++n) { const bf16x8 bv = *(const LAS bf16x8*)(lds + HG_KST + (n * 16 + r) * 144 + ks2 * 64 + kg * 16); st[n] = MFMA16(av, bv, st[n]); } }
    __syncthreads();
    if (tid < 128) nS[tid] = decay * nS[tid] + psum[tid] + psum[128 + tid] + psum[256 + tid] + psum[384 + tid];
    if (tid == 0) scal[1] = BtotA[scp] + Mall;
}

template <int DIR>
__device__ __forceinline__ void ml_gate_scans(const Args& a, LAS unsigned char* lds, int rowbase, int h) {
    const int tid = ltid(), lane = tid & 63, sub = tid >> 6;
    LAS float* mf = (LAS float*)(lds + HG_MISC);
    if (tid < 256) { const int tp = DIR ? 63 - lane : lane; const float* g = (const float*)(a.ws + WS_GATES) + (size_t)(rowbase + sub * 64 + tp) * 16;
        const float lf = logsig(g[(DIR ? 12 : 4) + h]), ig = g[(DIR ? 8 : 0) + h];
        const float b = wscan_add(lf, lane); const float c = ig - b; const float gmx = wscan_max(c, lane);
        const int idx = sub * 64 + tp; mf[1872 + idx] = c; mf[2128 + idx] = gmx; mf[2384 + idx] = b;
        if (lane == 63) { mf[2640 + sub] = b; mf[2644 + sub] = gmx; } }
}

__device__ void m3_ml2_item(const Args& a, LAS unsigned char* lds, int q) {
    const int tid = ltid(), lane = tid & 63, wave = tid >> 6, r = lane & 15, kg = lane >> 4;
    const int b = q >> 6, h = (q >> 4) & 3, j = (q & 15) + 1;
    const int rowbase = b * 4096 + (j - 1) * 256;
    const bf16_t* P = (const bf16_t*)(a.ws + WS_P);
    const bf16_t* mlst = (const bf16_t*)a.out;
    const float* ml_n = (const float*)(a.ws + WS_SMALL + SM_MLN); const float* ml_mpre = (const float*)(a.ws + WS_SMALL + SM_MPRE);
    bf16_t* Y = (bf16_t*)(a.ws + WS_Y);
    LAS float* mf = (LAS float*)(lds + HG_MISC); LAS float *nS = mf + 512, *scal = mf + 1088, *ssq = mf + 1744;
    const int seqF = (b * 4 + h) * 2, seqB = seqF + 1;
    const int slF = seqF * 16 + (j - 1), slB = seqB * 16 + (16 - j);
    const int mt = wave >> 1, hv = wave & 1;
    f32x4 st[8]; StageRegs R;
    __syncthreads();
    {
        const bf16_t* sp = mlst + (size_t)slF * 16384;
#pragma unroll
        for (int n = 0; n < 8; ++n)
#pragma unroll
            for (int jj = 0; jj < 4; ++jj) st[n][jj] = bf2f(sp[(wave * 16 + kg * 4 + jj) * 128 + n * 16 + r]);
        if (tid < 128) nS[tid] = ml_n[(size_t)slF * 128 + tid];
        if (tid == 0) scal[1] = ml_mpre[slF];
        ml_fetch<0>(a, rowbase, h, R);
        ml_gate_scans<0>(a, lds, rowbase, h);
#pragma unroll 1
        for (int scu = 0; scu < 4; ++scu) { f32x4 ho[4]; const int rb = rowbase + scu * 64;
            ml_sub<0>(a, lds, scu < 3 ? rb + 64 : -1, scu, h, st, ho, R);
            { u32x4* pk = (u32x4*)(a.ws + WS_PARK + (size_t)lbid() * 65536) + (scu * NT + tid) * 2;
              pk[0] = (u32x4){pack2(ho[0][0], ho[0][1]), pack2(ho[0][2], ho[0][3]), pack2(ho[1][0], ho[1][1]), pack2(ho[1][2], ho[1][3])};
              pk[1] = (u32x4){pack2(ho[2][0], ho[2][1]), pack2(ho[2][2], ho[2][3]), pack2(ho[3][0], ho[3][1]), pack2(ho[3][2], ho[3][3])}; } }
    }
    {
        const bf16_t* sp = mlst + (size_t)slB * 16384;
#pragma unroll
        for (int n = 0; n < 8; ++n)
#pragma unroll
            for (int jj = 0; jj < 4; ++jj) st[n][jj] = bf2f(sp[(wave * 16 + kg * 4 + jj) * 128 + n * 16 + r]);
        if (tid < 128) nS[tid] = ml_n[(size_t)slB * 128 + tid];
        if (tid == 0) scal[1] = ml_mpre[slB];
        ml_fetch<1>(a, rowbase + 192, h, R);
        ml_gate_scans<1>(a, lds, rowbase, h);
#pragma unroll 1
        for (int scu = 0; scu < 4; ++scu) { f32x4 ho[4]; const int rb = rowbase + (3 - scu) * 64;
            ml_sub<1>(a, lds, scu < 3 ? rb - 64 : -1, 3 - scu, h, st, ho, R);
            const u32x4* pkp = (const u32x4*)(a.ws + WS_PARK + (size_t)lbid() * 65536) + ((3 - scu) * NT + tid) * 2; const u32x4 pk0 = pkp[0], pk1 = pkp[1];
#pragma unroll
            for (int jj = 0; jj < 4; ++jj) { float ss = 0.f;
#pragma unroll
                for (int i = 0; i < 4; ++i) { const unsigned pw = (i < 2 ? pk0 : pk1)[(i & 1) * 2 + (jj >> 1)]; const float v = ho[i][jj] + ((jj & 1) ? hi_f(pw) : lo_f(pw)); ho[i][jj] = v; ss += v * v; }
                ss = red16(ss); if (r == 0) ssq[(mt * 16 + kg * 4 + jj) * 2 + hv] = ss; }
            __syncthreads();
#pragma unroll
            for (int jj = 0; jj < 4; ++jj) { const int t = mt * 16 + kg * 4 + jj; const float rs = rsqrtf((ssq[t * 2] + ssq[t * 2 + 1]) * (1.f / 128.f) + 1e-6f);
#pragma unroll
                for (int i = 0; i < 4; ++i) { const int col = h * 128 + hv * 64 + i * 16 + r; const float og = bf2f(P[(size_t)(rb + t) * NPC + 1536 + col]);
                    Y[(size_t)(rb + t) * 1024 + col] = f2bf(ho[i][jj] * rs * a.ml_norm_w[col] * og); } }
        }
    }
}

__device__ void phase_m3(const Args& a, LAS unsigned char* lds) {
    for (int it = lbid(); it < 1024; it += gridDim.x) {
        if (it < 512) m3_ml2_item(a, lds, it); else m3_hg_item(a, lds, it - 512);
    }
}

#define XB_TMO      128
#define XB_XCNT(j)  (256  + 64 * (j))
#define XB_XSUB(j)  (1280 + 64 * (j))
#define XB_XGEN(j)  (2304 + 64 * (j))
#define XB_TOP      3328
#define XB_TOPGEN   3392
#define XCD_BAR_WORDS 3456
#define XB_SPIN_CAP (1u << 18)
__device__ __forceinline__ unsigned xb_ld(unsigned* p)              { return __hip_atomic_load(p, __ATOMIC_RELAXED, __HIP_MEMORY_SCOPE_AGENT); }
__device__ __forceinline__ unsigned xb_add(unsigned* p, unsigned v) { return __hip_atomic_fetch_add(p, v, __ATOMIC_RELAXED, __HIP_MEMORY_SCOPE_AGENT); }
__device__ __forceinline__ unsigned xb_xcc_id() { return (unsigned)__builtin_amdgcn_s_getreg((3 << 11) | 20) & 0xFu; }
#define XB_SPIN(cond, bar) do { unsigned _sp = 0; while (cond) { __builtin_amdgcn_s_sleep(1); \
    if ((++_sp & 255u) == 0u) { if (xb_ld(&(bar)[XB_TMO])) break; if (_sp > XB_SPIN_CAP) { atomicAdd(&(bar)[XB_TMO], 1u); break; } } } } while (0)
struct XcdBarrier { unsigned* bar; unsigned x; volatile LAS unsigned* st; };
__device__ __forceinline__ XcdBarrier xcd_barrier_post(unsigned* bar, volatile LAS unsigned* st) {
    XcdBarrier b; b.bar = bar; b.x = xb_xcc_id(); b.st = st;
    if (threadIdx.x == 0) (void)xb_add(&bar[XB_XCNT(b.x)], 1u);
    return b;
}
__device__ __forceinline__ void xcd_barrier_complete(unsigned* bar, unsigned x, unsigned& nloc, unsigned& nx) {
    const unsigned G = gridDim.x * gridDim.y * gridDim.z;
    unsigned sum, cnt, mine, sp = 0u;
    for (;;) {
        sum = 0u; cnt = 0u; mine = 0u;
#pragma unroll
        for (unsigned j = 0; j < 16; ++j) { const unsigned c = xb_ld(&bar[XB_XCNT(j)]); sum += c; cnt += (c > 0u) ? 1u : 0u; mine = (j == x) ? c : mine; }
        if (sum == G) break;
        __builtin_amdgcn_s_sleep(1);
        if ((++sp & 255u) == 0u) { if (xb_ld(&bar[XB_TMO])) break; if (sp > XB_SPIN_CAP) { atomicAdd(&bar[XB_TMO], 1u); break; } }
    }
    nloc = mine > 0u ? mine : 1u; nx = cnt > 0u ? cnt : 1u;
}
__device__ __forceinline__ void xcd_barrier(const XcdBarrier& b) {
    asm volatile("s_waitcnt vmcnt(0)" ::: "memory");
    __syncthreads();
    if (threadIdx.x == 0) {
        unsigned* bar = b.bar;
        __builtin_amdgcn_s_waitcnt(0);
        unsigned nloc = b.st[0], nx = b.st[1];
        if (nloc == 0u) { xcd_barrier_complete(bar, b.x, nloc, nx); b.st[0] = nloc; b.st[1] = nx; }
        const unsigned old = xb_add(&bar[XB_XSUB(b.x)], 1u);
        const unsigned gen = old / nloc;
        if (old + 1u == (gen + 1u) * nloc) {
            __builtin_amdgcn_fence(__ATOMIC_RELEASE, "agent");
            asm volatile("s_waitcnt vmcnt(0)" ::: "memory");
            const unsigned og = xb_add(&bar[XB_TOP], 1u);
            const unsigned tg = og / nx;
            if (og + 1u == (tg + 1u) * nx) xb_add(&bar[XB_TOPGEN], 1u);
            else XB_SPIN(xb_ld(&bar[XB_TOPGEN]) == tg, bar);
            __builtin_amdgcn_fence(__ATOMIC_ACQUIRE, "agent");
            xb_add(&bar[XB_XGEN(b.x)], 1u);
            asm volatile("s_waitcnt vmcnt(0)" ::: "memory");
        } else {
            XB_SPIN(xb_ld(&bar[XB_XGEN(b.x)]) == gen, bar);
            __builtin_amdgcn_fence(__ATOMIC_ACQUIRE, "agent");
            asm volatile("s_waitcnt vmcnt(0)" ::: "memory");
        }
    }
    __syncthreads();
}
constexpr size_t WS_BAR = WS_SMALL + 1536 * 1024;

constexpr int N_PHASES = 14;
__global__ void __launch_bounds__(NT, 2) mega(Args a) {
    extern __shared__ __attribute__((aligned(16))) unsigned char lds_raw[];
    LAS unsigned char* lds = (LAS unsigned char*)lds_raw;
    cg::grid_group grid = cg::this_grid();
    const int G = gridDim.x, bid = lbid();
    volatile LAS unsigned* stw = (volatile LAS unsigned*)(lds + LDS_BYTES - 16);
    if (threadIdx.x == 0) { stw[0] = 0u; stw[1] = 0u; }
    __syncthreads();
    const XcdBarrier bar = xcd_barrier_post((unsigned*)(a.ws + WS_BAR), stw);
    const int ph_lo = a.ph_lo, ph_hi = a.ph_hi;
    if (ph_lo < 0) grid.sync();
    for (int ph = ph_lo; ph < ph_hi; ++ph) {
        { __attribute__((address_space(1))) unsigned char* w = (__attribute__((address_space(1))) unsigned char*)a.ws; __attribute__((address_space(1))) float* o = (__attribute__((address_space(1))) float*)a.out;
          asm volatile("" : "+s"(w), "+s"(o)); a.ws = (unsigned char*)w; a.out = (float*)o; }
        switch (ph) {
        case 0: phase_p0(a, lds); break;
        case 1: phase_p1(a, lds); break;
        case 2: { pg8::Gemm g{(const bf16_t*)(a.ws + WS_R1), nullptr, 1 << 30, (const bf16_t*)(a.ws + WS_WIN), NROWS, NPC, 1024}; pg8::StaticOrder S; S.init(NROWS, NPC, G, bid);
                  pg8::EpiBf16<true> E{(bf16_t*)(a.ws + WS_P), NPC}; pg8::gemm_phase(lds, g, S, E); } break;
        case 3: phase_mc(a); break;
        case 4: phase_m1(a, lds); break;
        case 5: phase_m2(a); break;
        case 6: phase_m3(a, lds); break;
        case 7: { pg8::Gemm g{(const bf16_t*)(a.ws + WS_Y), nullptr, 1 << 30, (const bf16_t*)(a.ws + WS_WOUT), NLAT, 1024, 1024}; pg8::StaticOrder S; S.init(NLAT, 1024, G, bid);
                  pg8::EpiRes E{a.x, a.out, (const float*)(a.ws + WS_MOD) + 2048}; pg8::gemm_phase(lds, g, S, E); } break;
        case 8: phase_n2(a); break;
        case 9: { pg8::Gemm g{(const bf16_t*)(a.ws + WS_A2), nullptr, 1 << 30, (const bf16_t*)(a.ws + WS_WUP), NLAT, 5632, 1024}; pg8::StaticOrder S; S.init(NLAT, 5632, G, bid);
                  pg8::EpiBf16<false> E{(bf16_t*)(a.ws + WS_U), 5632}; pg8::gemm_phase(lds, g, S, E); } break;
        case 10: phase_cv(a, 0, (bf16_t*)(a.ws + WS_ACTA)); break;
        case 11: phase_cv(a, 4, (bf16_t*)(a.ws + WS_ACTB)); break;
        case 12: { pg8::Gemm g{(const bf16_t*)(a.ws + WS_ACTA), (const bf16_t*)(a.ws + WS_ACTB), 64, (const bf16_t*)(a.ws + WS_WDN), NLAT, 1024, 2816}; pg8::StaticOrder S; S.init(NLAT, 1024, G, bid);
                  pg8::EpiRes E{a.out, a.out, (const float*)(a.ws + WS_MOD) + 5120}; pg8::gemm_phase(lds, g, S, E); } break;
        case 13: phase_fn(a); break;
        }
        if (ph + 1 < ph_hi) xcd_barrier(bar);
    }
}

extern "C" void kernel_launch(void* const* d_in, const int* in_sizes, int n_in, void* d_out, int out_size, void* d_ws, size_t ws_size, hipStream_t stream) {
    static int grid = 0;
    if (grid == 0) {
        if (n_in != 19 || ws_size < WS_NEED) { fprintf(stderr, "kernel_launch: unexpected n_in %d / ws_size %zu\n", n_in, ws_size); grid = -1; return; }
        int dev = 0, cus = 0, per_cu = 0;
        (void)hipGetDevice(&dev); (void)hipDeviceGetAttribute(&cus, hipDeviceAttributeMultiprocessorCount, dev);
        if (hipFuncSetAttribute((const void*)mega, hipFuncAttributeMaxDynamicSharedMemorySize, LDS_BYTES) != hipSuccess) { fprintf(stderr, "kernel_launch: hipFuncSetAttribute failed\n"); grid = -1; return; }
        if (hipOccupancyMaxActiveBlocksPerMultiprocessor(&per_cu, (const void*)mega, NT, LDS_BYTES) != hipSuccess || per_cu < 1) { fprintf(stderr, "kernel_launch: occupancy query says %d\n", per_cu); per_cu = 1; }
        (void)hipGetLastError();
        grid = cus;
    }
    if (grid < 0) return;
    Args a{};
    const float** ip = (const float**)&a;
    for (int i = 0; i < 19; ++i) ip[i] = (const float*)d_in[i];
    a.out = (float*)d_out; a.ws = (unsigned char*)d_ws;
    (void)hipMemsetAsync((unsigned char*)d_ws + WS_BAR, 0, XCD_BAR_WORDS * sizeof(unsigned), stream);
    a.ph_lo = 0; a.ph_hi = N_PHASES; void* args[] = {&a};
    hipError_t e = hipLaunchCooperativeKernel((const void*)mega, dim3(grid), dim3(NT), args, LDS_BYTES, stream);
    if (e != hipSuccess) fprintf(stderr, "cooperative launch failed: %s (grid %d)\n", hipGetErrorString(e), grid);
}
```
